# Optimizing an MI355X kernel written in HIP

```python
import jax, jax.numpy as jnp
from jax import lax
import numpy as np

D_MODEL = 2048
BATCH = 8
SEQ = 4096
DEPTH = 2
DEC_BATCH = 8
DEC_SEQ = 64
PAST_LEN = 1024

CHUNK = 64
Q_BLOCK = 128
EPS = 1e-6
ROPE_THETA = 10000.0
MLSTM_H = 4
MLSTM_DK = 128
MLSTM_DV = 256
MLA_H = 8
MLA_NOPE = 128
MLA_ROPE = 64
MLA_V = 128
MLA_Q_LORA = 512
MLA_KV_LORA = 512
RET_H = 4
RET_DK = 128
RET_DV = 256
D_FF = ((8 * D_MODEL + 3 * 256 - 1) // (3 * 256)) * 256
IN_SPLITS = (
    MLSTM_H * MLSTM_DK, MLSTM_H * MLSTM_DK, MLSTM_H * MLSTM_DV, MLSTM_H * MLSTM_DV, MLSTM_H, MLSTM_H,
    MLA_Q_LORA, MLA_KV_LORA, MLA_ROPE,
    RET_H * RET_DK, RET_H * RET_DK, RET_H * RET_DV, RET_H * RET_DV,
    D_MODEL, D_MODEL, D_MODEL,
)
D_IN = sum(IN_SPLITS)

kernel_name = 'hybrid_mlstm_mla_retention_stream_step'


def rmsnorm(x, g):
    x32 = x.astype(jnp.float32)
    y = x32 * lax.rsqrt(jnp.mean(x32 * x32, axis=-1, keepdims=True) + EPS)
    return (y * g.astype(jnp.float32)).astype(x.dtype)


def head_norm(x, g, center):
    if center:
        x = x - jnp.mean(x, axis=-1, keepdims=True)
    x = x * lax.rsqrt(jnp.mean(x * x, axis=-1, keepdims=True) + EPS)
    return x.reshape(x.shape[:2] + (-1,)) * g.astype(jnp.float32)


def rope(x, pos):
    d = x.shape[-1]
    inv = 1.0 / (ROPE_THETA ** (jnp.arange(0, d, 2, dtype=jnp.float32) / d))
    ang = pos.astype(jnp.float32)[:, None] * inv[None, :]
    ang = ang.reshape((ang.shape[0],) + (1,) * (x.ndim - 3) + (d // 2,))
    cos, sin = jnp.cos(ang), jnp.sin(ang)
    x32 = x.astype(jnp.float32)
    x1, x2 = x32[..., : d // 2], x32[..., d // 2:]
    return jnp.concatenate([x1 * cos - x2 * sin, x1 * sin + x2 * cos], axis=-1).astype(x.dtype)


def run_chunks(step, carry, xs):
    S = xs[0].shape[1]
    if S <= CHUNK:
        return step(carry, xs)
    nc = S // CHUNK
    xs_c = tuple(jnp.moveaxis(a.reshape((a.shape[0], nc, CHUNK) + a.shape[2:]), 1, 0) for a in xs)
    carry, ys = lax.scan(step, carry, xs_c)
    ys = jnp.moveaxis(ys, 0, 1)
    return carry, ys.reshape((ys.shape[0], S) + ys.shape[3:])


def mlstm_step(carry, xs):
    c, n, m = carry
    q, k, v, ig, lf = xs
    L = q.shape[1]
    b = jnp.cumsum(lf, axis=1).transpose(0, 2, 1)
    i_t = ig.transpose(0, 2, 1)
    causal = jnp.tril(jnp.ones((L, L), dtype=bool))
    log_d = jnp.where(causal, b[..., :, None] - b[..., None, :] + i_t[..., None, :], -jnp.inf)
    log_prev = b + m[..., None]
    m_t = jnp.maximum(log_prev, jnp.max(log_d, axis=-1))
    dmat = jnp.exp(log_d - m_t[..., None])
    prev_scale = jnp.exp(log_prev - m_t)
    w = jnp.einsum('blhd,bshd->bhls', q, k) * dmat
    num = jnp.einsum('bhls,bshv->blhv', w, v) + jnp.einsum('bhl,bhvd,blhd->blhv', prev_scale, c, q)
    den = jnp.sum(w, axis=-1) + prev_scale * jnp.einsum('bhd,blhd->bhl', n, q)
    h = num / jnp.maximum(jnp.abs(den), jnp.exp(-m_t)).transpose(0, 2, 1)[..., None]
    b_last = b[..., -1]
    log_s = b_last[..., None] - b + i_t
    m_new = jnp.maximum(b_last + m, jnp.max(log_s, axis=-1))
    ws = jnp.exp(log_s - m_new[..., None])
    carry_scale = jnp.exp(b_last + m - m_new)
    c_new = carry_scale[..., None, None] * c + jnp.einsum('bhs,bshv,bshd->bhvd', ws, v, k)
    n_new = carry_scale[..., None] * n + jnp.einsum('bhs,bshd->bhd', ws, k)
    return (c_new, n_new, m_new), h


def ret_step(r, xs):
    q, k, v = xs
    L = q.shape[1]
    lg = jnp.log1p(-jnp.exp2(-5.0 - jnp.arange(RET_H, dtype=jnp.float32)))
    idx = jnp.arange(L, dtype=jnp.float32)
    diff = idx[:, None] - idx[None, :]
    dmat = jnp.where(diff >= 0, jnp.exp(jnp.maximum(diff, 0.0)[None] * lg[:, None, None]), 0.0)
    inner = jnp.einsum('blhd,bshd->bhls', q, k) * dmat[None]
    xi = jnp.exp((idx[:, None] + 1.0) * lg[None, :])
    out = jnp.einsum('bhls,bshv->blhv', inner, v) + jnp.einsum('blhd,bhdv->blhv', q, r) * xi[None, :, :, None]
    zeta = jnp.exp((L - 1.0 - idx)[:, None] * lg[None, :])
    r_new = jnp.exp(L * lg)[None, :, None, None] * r + jnp.einsum('bshd,bshv,sh->bhdv', k, v, zeta)
    return r_new, out


def chunk_causal_attention(q, k, v, q_pos, k_pos):
    B, Q, H, _ = q.shape
    Dv = v.shape[-1]
    scale = q.shape[-1] ** -0.5
    k_chunk = k_pos // CHUNK

    def attend(qb, qpb):
        s = jnp.einsum('bqhd,bkhd->bhqk', qb, k).astype(jnp.float32) * scale
        mask = k_chunk[None, :] <= (qpb // CHUNK)[:, None]
        s = jnp.where(mask[None, None], s, -1e30)
        p = jax.nn.softmax(s, axis=-1).astype(v.dtype)
        return jnp.einsum('bhqk,bkhd->bqhd', p, v)

    if Q <= Q_BLOCK:
        return attend(q, q_pos)
    nb = Q // Q_BLOCK
    qb = jnp.moveaxis(q.reshape(B, nb, Q_BLOCK, H, q.shape[-1]), 1, 0)
    pb = q_pos.reshape(nb, Q_BLOCK)
    out = lax.map(lambda a: attend(a[0], a[1]), (qb, pb))
    return jnp.moveaxis(out, 0, 1).reshape(B, Q, H, Dv)


def token_mixers(h, pos0, ckv_past, kr_past, c0, n0, m0, r0, w_in, b_in, g_mlstm, w_up_m,
                 g_qa, w_uq, g_kva, w_ukv, w_up_a, g_ret, w_up_r, w_o):
    f32 = jnp.float32
    B, S, _ = h.shape
    pos = pos0 + jnp.arange(S, dtype=jnp.int32)
    z = h @ w_in + b_in
    split_at = np.cumsum(IN_SPLITS)[:-1].tolist()
    (mq, mk, mv, mo, mi, mf, a_dq, a_dkv, a_kr, rq, rk, rv, rg,
     gate_m, gate_a, gate_r) = jnp.split(z, split_at, axis=-1)

    q = mq.reshape(B, S, MLSTM_H, MLSTM_DK).astype(f32)
    k = mk.reshape(B, S, MLSTM_H, MLSTM_DK).astype(f32) * (MLSTM_DK ** -0.5)
    v = mv.reshape(B, S, MLSTM_H, MLSTM_DV).astype(f32)
    ig = mi.astype(f32)
    lf = jax.nn.log_sigmoid(mf.astype(f32))
    (c1, n1, m1), hm = run_chunks(mlstm_step, (c0.astype(f32), n0.astype(f32), m0.astype(f32)),
                                  (q, k, v, ig, lf))
    ym = head_norm(hm, g_mlstm, False) * jax.nn.sigmoid(mo.astype(f32))
    u_m = ym.astype(h.dtype) @ w_up_m

    qa = (rmsnorm(a_dq, g_qa) @ w_uq).reshape(B, S, MLA_H, MLA_NOPE + MLA_ROPE)
    qa = jnp.concatenate([qa[..., :MLA_NOPE], rope(qa[..., MLA_NOPE:], pos)], axis=-1)
    ckv = rmsnorm(a_dkv, g_kva)
    kr = rope(a_kr, pos)
    ckv_all = jnp.concatenate([ckv_past.astype(h.dtype), ckv], axis=1)
    kr_all = jnp.concatenate([kr_past.astype(h.dtype), kr], axis=1)
    K = ckv_all.shape[1]
    kv = (ckv_all @ w_ukv).reshape(B, K, MLA_H, MLA_NOPE + MLA_V)
    ka = jnp.concatenate([kv[..., :MLA_NOPE],
                          jnp.broadcast_to(kr_all[:, :, None, :], (B, K, MLA_H, MLA_ROPE))], axis=-1)
    ya = chunk_causal_attention(qa, ka, kv[..., MLA_NOPE:], pos, jnp.arange(K, dtype=jnp.int32))
    u_a = ya.reshape(B, S, MLA_H * MLA_V) @ w_up_a

    q = rope(rq.reshape(B, S, RET_H, RET_DK), pos).astype(f32)
    k = rope(rk.reshape(B, S, RET_H, RET_DK), pos).astype(f32) * (RET_DK ** -0.5)
    v = rv.reshape(B, S, RET_H, RET_DV).astype(f32)
    r1, yr = run_chunks(ret_step, r0.astype(f32), (q, k, v))
    yr = head_norm(yr, g_ret, True) * jax.nn.silu(rg.astype(f32))
    u_r = yr.astype(h.dtype) @ w_up_r

    merged = (jax.nn.sigmoid(gate_m) * u_m + jax.nn.sigmoid(gate_a) * u_a
              + jax.nn.sigmoid(gate_r) * u_r)
    return merged @ w_o, (ckv, kr, c1, n1, m1, r1)


def swiglu(h, w_gu, w_down):
    a, g = jnp.split(h @ w_gu, 2, axis=-1)
    return (jax.nn.silu(g) * a) @ w_down


def run_trunk(x, pos0, past_ckv, past_kr, c0, n0, m0, r0, params):
    (g_mix_pre, w_in, b_in, g_mlstm, w_up_m, g_qa, w_uq, g_kva, w_ukv, w_up_a, g_ret, w_up_r,
     w_o, g_mix_post, g_ffn_pre, w_gu, w_down, g_ffn_post) = params
    outs = [[] for _ in range(6)]
    for l in range(DEPTH):
        h = rmsnorm(x, g_mix_pre[l])
        mix, st = token_mixers(h, pos0, past_ckv[l], past_kr[l], c0[l], n0[l], m0[l], r0[l],
                               w_in[l], b_in[l], g_mlstm[l], w_up_m[l], g_qa[l], w_uq[l],
                               g_kva[l], w_ukv[l], w_up_a[l], g_ret[l], w_up_r[l], w_o[l])
        x = x + rmsnorm(mix, g_mix_post[l])
        h = rmsnorm(x, g_ffn_pre[l])
        x = x + rmsnorm(swiglu(h, w_gu[l], w_down[l]), g_ffn_post[l])
        for lst, s in zip(outs, st):
            lst.append(s.astype(x.dtype))
    return x, [jnp.stack(lst) for lst in outs]


def setup_inputs(seed: int = 0) -> dict:
    key = jax.random.key(seed)
    ks = jax.random.split(key, 32)
    f32 = jnp.float32

    def nrm(k, shape, scale):
        return jax.random.normal(k, shape, f32) * scale

    def gain(k, shape):
        return 1.0 + 0.01 * jax.random.normal(k, shape, f32)

    f_off = sum(IN_SPLITS[:5])
    b_in = nrm(ks[10], (DEPTH, D_IN), 0.01)
    b_in = b_in.at[:, f_off:f_off + MLSTM_H].add(jnp.linspace(3.0, 6.0, MLSTM_H))
    return {
        'x_prompt': nrm(ks[0], (BATCH, SEQ, D_MODEL), 1.0),
        'x_sample': nrm(ks[1], (DEC_BATCH, DEC_SEQ, D_MODEL), 1.0),
        'cache_mla_ckv': nrm(ks[2], (DEPTH, DEC_BATCH, PAST_LEN, MLA_KV_LORA), 1.0),
        'cache_mla_krope': nrm(ks[3], (DEPTH, DEC_BATCH, PAST_LEN, MLA_ROPE), 1.0),
        'state_mlstm_c': nrm(ks[4], (DEPTH, DEC_BATCH, MLSTM_H, MLSTM_DV, MLSTM_DK), 1.0),
        'state_mlstm_n': nrm(ks[5], (DEPTH, DEC_BATCH, MLSTM_H, MLSTM_DK), 1.0),
        'state_mlstm_m': nrm(ks[6], (DEPTH, DEC_BATCH, MLSTM_H), 0.5),
        'state_ret': nrm(ks[7], (DEPTH, DEC_BATCH, RET_H, RET_DK, RET_DV), 1.0),
        'g_mix_pre': gain(ks[8], (DEPTH, D_MODEL)),
        'w_in': nrm(ks[9], (DEPTH, D_MODEL, D_IN), D_MODEL ** -0.5),
        'b_in': b_in,
        'g_mlstm': gain(ks[11], (DEPTH, MLSTM_H * MLSTM_DV)),
        'w_up_m': nrm(ks[12], (DEPTH, MLSTM_H * MLSTM_DV, D_MODEL), (MLSTM_H * MLSTM_DV) ** -0.5),
        'g_qa': gain(ks[13], (DEPTH, MLA_Q_LORA)),
        'w_uq': nrm(ks[14], (DEPTH, MLA_Q_LORA, MLA_H * (MLA_NOPE + MLA_ROPE)), MLA_Q_LORA ** -0.5),
        'g_kva': gain(ks[15], (DEPTH, MLA_KV_LORA)),
        'w_ukv': nrm(ks[16], (DEPTH, MLA_KV_LORA, MLA_H * (MLA_NOPE + MLA_V)), MLA_KV_LORA ** -0.5),
        'w_up_a': nrm(ks[17], (DEPTH, MLA_H * MLA_V, D_MODEL), (MLA_H * MLA_V) ** -0.5),
        'g_ret': gain(ks[18], (DEPTH, RET_H * RET_DV)),
        'w_up_r': nrm(ks[19], (DEPTH, RET_H * RET_DV, D_MODEL), (RET_H * RET_DV) ** -0.5),
        'w_o': nrm(ks[20], (DEPTH, D_MODEL, D_MODEL), D_MODEL ** -0.5),
        'g_mix_post': gain(ks[21], (DEPTH, D_MODEL)),
        'g_ffn_pre': gain(ks[22], (DEPTH, D_MODEL)),
        'w_gu': nrm(ks[23], (DEPTH, D_MODEL, 2 * D_FF), D_MODEL ** -0.5),
        'w_down': nrm(ks[24], (DEPTH, D_FF, D_MODEL), D_FF ** -0.5),
        'g_ffn_post': gain(ks[25], (DEPTH, D_MODEL)),
    }


def reference(x_prompt, x_sample, cache_mla_ckv, cache_mla_krope, state_mlstm_c, state_mlstm_n,
              state_mlstm_m, state_ret, g_mix_pre, w_in, b_in, g_mlstm, w_up_m, g_qa, w_uq, g_kva,
              w_ukv, w_up_a, g_ret, w_up_r, w_o, g_mix_post, g_ffn_pre, w_gu, w_down, g_ffn_post):
    params = (g_mix_pre, w_in, b_in, g_mlstm, w_up_m, g_qa, w_uq, g_kva, w_ukv, w_up_a, g_ret,
              w_up_r, w_o, g_mix_post, g_ffn_pre, w_gu, w_down, g_ffn_post)
    dt = x_prompt.dtype
    B = x_prompt.shape[0]
    y_prompt, (p_ckv, p_kr, p_c, p_n, p_m, p_r) = run_trunk(
        x_prompt, 0,
        jnp.zeros((DEPTH, B, 0, MLA_KV_LORA), dt), jnp.zeros((DEPTH, B, 0, MLA_ROPE), dt),
        jnp.zeros((DEPTH, B, MLSTM_H, MLSTM_DV, MLSTM_DK), dt), jnp.zeros((DEPTH, B, MLSTM_H, MLSTM_DK), dt),
        jnp.zeros((DEPTH, B, MLSTM_H), dt), jnp.zeros((DEPTH, B, RET_H, RET_DK, RET_DV), dt),
        params)
    y_sample, (s_ckv, s_kr, s_c, s_n, s_m, s_r) = run_trunk(
        x_sample, cache_mla_ckv.shape[2], cache_mla_ckv, cache_mla_krope,
        state_mlstm_c, state_mlstm_n, state_mlstm_m, state_ret, params)
    return (y_prompt, y_sample, p_ckv, p_kr, p_c, p_n, p_m, p_r,
            s_ckv, s_kr, s_c, s_n, s_m, s_r)
```

```cpp
#include <hip/hip_runtime.h>
#include <hip/hip_cooperative_groups.h>
#include <cstdio>
#include <cstdint>
namespace cg = cooperative_groups;
namespace pg8 {
#define PG8_LAS __attribute__((address_space(3)))
typedef unsigned short bf16_t;
typedef short bf16x8 __attribute__((ext_vector_type(8)));
typedef float f32x4 __attribute__((ext_vector_type(4)));
typedef unsigned u32x4 __attribute__((ext_vector_type(4)));
constexpr int BM = 256, BK = 64, HALF = 128, HTB = HALF * BK * 2  , STAGE_BYTES = 8 * HTB, NXCD = 8, WGM = 8;

__host__ __device__ __forceinline__ int lds_byte(int r, int c) { const int st = (r >> 4) * 2 + (c >> 5), rr = r & 15, cc = c & 31, ob = rr * 64 + cc * 2; return st * 1024 + (ob ^ (((ob >> 9) & 1) << 5)); }
__host__ __device__ __forceinline__ void stage_rc(int b, int& R, int& C) { const int st = b / 1024, sb = b % 1024, swz = sb ^ (((sb >> 9) & 1) << 5); R = (st >> 1) * 16 + swz / 64; C = (st & 1) * 32 + (swz % 64) / 2; }
__host__ __device__ __forceinline__ int perm32(int rho) { const int n = rho >> 4, i = rho & 15; return 8 * (i >> 2) + 4 * n + (i & 3); }

struct Unit { int pm, pn; int seg = 0; };
struct Gemm { const bf16_t* A; const bf16_t* Bt; int M, N, K; int ld = 0, nMr = 1 << 20, kslice = 0; const bf16_t* A1 = nullptr; const bf16_t* Bt1 = nullptr; const bf16_t* A2 = nullptr; const bf16_t* Bt2 = nullptr; };

struct StaticOrder {
    int nM, nN, nwg, G, c;
    __host__ __device__ void init(int M, int N, int G_, int c_) { nM = M / BM; nN = N / BM; nwg = nM * nN; G = G_; c = c_; }
    __host__ __device__ bool next(int i, Unit& u) const {
        const long L = (long)i * G + c; if (L >= nwg) return false;
        int wgid = (int)L; { const int q = nwg / NXCD, r = nwg % NXCD, xcd = wgid % NXCD, off = wgid / NXCD; wgid = (xcd < r ? xcd * (q + 1) : r * (q + 1) + (xcd - r) * q) + off; }
        const int nig = WGM * nN, gid = wgid / nig, fm = gid * WGM, gsz = (nM - fm) < WGM ? (nM - fm) : WGM;
        u.pm = fm + ((wgid % nig) % gsz); u.pn = (wgid % nig) / gsz; return true;
    }
    __device__ __forceinline__ void a_ready(const Unit&) const {}
    __device__ __forceinline__ void done(const Unit&) const {}
};


struct TriOrder {
    int n0, n1, n2, nN0, nN1, nN2, G, c;
    __host__ __device__ void init(int nM0_, int nN0_, int nM1_, int nN1_, int nM2_, int nN2_, int G_, int c_) { nN0 = nN0_; nN1 = nN1_; nN2 = nN2_; n0 = nM0_ * nN0_; n1 = nM1_ * nN1_; n2 = nM2_ * nN2_; G = G_; c = c_; }
    __host__ __device__ bool next(int i, Unit& u) const {
        int L = i * G + c; if (L >= n0 + n1 + n2) return false;
        if (L < n0) { u.seg = 0; u.pm = L / nN0; u.pn = L % nN0; return true; } L -= n0;
        if (L < n1) { u.seg = 1; u.pm = L / nN1; u.pn = L % nN1; return true; } L -= n1;
        u.seg = 2; u.pm = L / nN2; u.pn = L % nN2; return true;
    }
    __device__ __forceinline__ void a_ready(const Unit&) const {}
    __device__ __forceinline__ void done(const Unit&) const {}
};

struct ChunkOrder {
    int nN, G, c; unsigned* ready;
    __host__ __device__ void init(int nN_, int G_, int c_, unsigned* ready_) { nN = nN_; G = G_; c = c_; ready = ready_; }
    __host__ __device__ bool next(int i, Unit& u) const {
        int L = i * G + c; const int per = 8 * nN, nmain = 16 * per;
        if (L >= nmain + 2 * nN) return false;
        if (L < nmain) { const int t = L / per, idx = L % per; u.pm = (idx & 7) * 16 + t; u.pn = idx >> 3; return true; }
        L -= nmain; u.pm = 128 + (L & 1); u.pn = L >> 1; return true;
    }
    __device__ __forceinline__ void a_ready(const Unit&) const {}
    __device__ __forceinline__ void done(const Unit& u) const {
        asm volatile("s_waitcnt vmcnt(0)" ::: "memory");
        if ((threadIdx.x & 63) == 0) __hip_atomic_fetch_add(ready + 16 * u.pm, 1u, __ATOMIC_RELAXED, __HIP_MEMORY_SCOPE_AGENT);
    }
};
__device__ __forceinline__ unsigned cvt_pk_bf16(float lo, float hi) { unsigned r; asm volatile("v_cvt_pk_bf16_f32 %0, %1, %2" : "=v"(r) : "v"(lo), "v"(hi)); return r; }
__device__ __forceinline__ float bflo(unsigned w) { return __uint_as_float(w << 16); }
__device__ __forceinline__ float bfhi(unsigned w) { return __uint_as_float(w & 0xffff0000u); }
__device__ __forceinline__ float sigm(float v) { return __builtin_amdgcn_rcpf(1.0f + __expf(-v)); }
constexpr int ZSW = 6400, ZRW = 7424, ZW = ZSW + ZRW;
constexpr int ZS_MQ = 0, ZS_MK = 512, ZS_MV = 1024, ZS_MO = 2048, ZS_RQ = 3072, ZS_RK = 3584, ZS_RV = 4096, ZS_RG = 5120, ZS_MISC = 6144;
constexpr int ZR_DQ = 0, ZR_DKV = 512, ZR_KR = 1024, ZR_GM = 1280, ZR_GA = 3328, ZR_GR = 5376;

struct EpiBf16 {
    static constexpr bool PERM = true, AFTER_DRAIN = false, HOOK = false;
    bf16_t* O; int ldc; const float* bias; int actmode; int hook_t0, hook_t1; bf16_t* O1 = nullptr; int ldc1 = 0; bf16_t* O2 = nullptr; int ldc2 = 0;
    __device__ __forceinline__ void hook(f32x4 (&acc)[2][2][4][2], const Unit& u, int t, int wr, int wc, int fr, int fq) const {}
    __device__ __forceinline__ void operator()(const f32x4 (&acc)[2][2][4][2], const Unit& u, int wr, int wc, int fr, int fq) const {
        const bool wt = (actmode & 256) != 0; const int actmode_ = actmode & 255;
        int act = 0; { const int pn = u.pn; if (actmode_ == 1) act = (pn >= 8 && pn < 12) ? 1 : ((pn >= 20 && pn < 24) ? 2 : 0); else if (actmode_ == 2) act = pn >= 5 ? 1 : 0; }
        const int row0 = u.pm * BM + wr * 64 + fr; const int col0 = u.pn * BM + wc * 32 + 8 * fq;
        bf16_t* o0_ = O; bf16_t* o1_ = O1; bf16_t* o2_ = O2; int l0_ = ldc, l1_ = ldc1, l2_ = ldc2;
        asm volatile("" : "+s"(o0_), "+s"(o1_), "+s"(o2_), "+s"(l0_), "+s"(l1_), "+s"(l2_));
        bf16_t* Os = u.seg == 0 ? o0_ : (u.seg == 1 ? o1_ : o2_); const int lds_ = u.seg == 0 ? l0_ : (u.seg == 1 ? l1_ : l2_);
        f32x4 bv[2][2];
#pragma unroll
        for (int bj = 0; bj < 2; ++bj)
#pragma unroll
            for (int n = 0; n < 2; ++n) bv[bj][n] = bias ? *(const f32x4*)(bias + col0 + bj * HALF + 4 * n) : (f32x4){0.f, 0.f, 0.f, 0.f};
#pragma unroll
        for (int ai = 0; ai < 2; ++ai)
#pragma unroll
            for (int m = 0; m < 4; ++m) { bf16_t* rowp = Os + (size_t)(row0 + ai * HALF + m * 16) * lds_ + col0;
#pragma unroll
                for (int bj = 0; bj < 2; ++bj) { f32x4 v0 = acc[ai][bj][m][0] + bv[bj][0], v1 = acc[ai][bj][m][1] + bv[bj][1];
                    if (act == 1) {
#pragma unroll
                        for (int k = 0; k < 4; ++k) { v0[k] = sigm(v0[k]); v1[k] = sigm(v1[k]); }
                    } else if (act == 2) {
#pragma unroll
                        for (int k = 0; k < 4; ++k) { v0[k] = v0[k] * sigm(v0[k]); v1[k] = v1[k] * sigm(v1[k]); }
                    }
                    u32x4 w; w.x = cvt_pk_bf16(v0[0], v0[1]); w.y = cvt_pk_bf16(v0[2], v0[3]); w.z = cvt_pk_bf16(v1[0], v1[1]); w.w = cvt_pk_bf16(v1[2], v1[3]);
                    if (wt) asm volatile("global_store_dwordx4 %0, %1, off sc0 sc1" :: "v"(rowp + bj * HALF), "v"(w) : "memory");
                    else *(u32x4*)(rowp + bj * HALF) = w; } }
    }
};

struct EpiUp {
    static constexpr bool PERM = true, AFTER_DRAIN = false, HOOK = true;
    bf16_t* O; int ldc; const bf16_t* Zg; int hook_t0, hook_t1;
    __device__ __forceinline__ void hook(f32x4 (&acc)[2][2][4][2], const Unit& u, int t, int wr, int wc, int fr, int fq) const {
        const int cn = (t == hook_t0) ? ZR_GM : ZR_GA;
        int frl = fr, fql = fq; asm volatile("" : "+v"(frl), "+v"(fql));
        const char* zb = (const char*)(Zg + (size_t)(u.pm * BM + wr * 64) * ZRW + u.pn * BM + wc * 32 + cn);
        const unsigned lo = (unsigned)(frl * ZRW + 8 * fql) * 2u;
#pragma unroll
        for (int ai = 0; ai < 2; ++ai) {
            u32x4 gn[4][2], gd[4][2];
#pragma unroll
            for (int m = 0; m < 4; ++m) { const char* zr = zb + (lo + (unsigned)((ai * HALF + m * 16) * ZRW) * 2u);
#pragma unroll
                for (int bj = 0; bj < 2; ++bj) { gn[m][bj] = *(const u32x4*)(zr + bj * HALF * 2); gd[m][bj] = *(const u32x4*)(zr + 4096 + bj * HALF * 2); } }
#pragma unroll
            for (int m = 0; m < 4; ++m)
#pragma unroll
                for (int bj = 0; bj < 2; ++bj) { const u32x4 a = gn[m][bj], d = gd[m][bj];
                    f32x4 r0, r1;
                    r0[0] = bflo(a.x) * __builtin_amdgcn_rcpf(fmaxf(bflo(d.x), 1e-30f)); r0[1] = bfhi(a.x) * __builtin_amdgcn_rcpf(fmaxf(bfhi(d.x), 1e-30f));
                    r0[2] = bflo(a.y) * __builtin_amdgcn_rcpf(fmaxf(bflo(d.y), 1e-30f)); r0[3] = bfhi(a.y) * __builtin_amdgcn_rcpf(fmaxf(bfhi(d.y), 1e-30f));
                    r1[0] = bflo(a.z) * __builtin_amdgcn_rcpf(fmaxf(bflo(d.z), 1e-30f)); r1[1] = bfhi(a.z) * __builtin_amdgcn_rcpf(fmaxf(bfhi(d.z), 1e-30f));
                    r1[2] = bflo(a.w) * __builtin_amdgcn_rcpf(fmaxf(bflo(d.w), 1e-30f)); r1[3] = bfhi(a.w) * __builtin_amdgcn_rcpf(fmaxf(bfhi(d.w), 1e-30f));
                    acc[ai][bj][m][0] = acc[ai][bj][m][0] * r0; acc[ai][bj][m][1] = acc[ai][bj][m][1] * r1; }
            __builtin_amdgcn_sched_barrier(0);
        }
    }
    __device__ __forceinline__ void operator()(const f32x4 (&acc)[2][2][4][2], const Unit& u, int wr, int wc, int fr, int fq) const {
        const int row0 = u.pm * BM + wr * 64 + fr; const int col0 = u.pn * BM + wc * 32 + 8 * fq;
#pragma unroll
        for (int ai = 0; ai < 2; ++ai)
#pragma unroll
            for (int m = 0; m < 4; ++m) { const size_t rr = (size_t)(row0 + ai * HALF + m * 16); const bf16_t* zr = Zg + rr * ZRW + ZR_GR + col0; bf16_t* rowp = O + rr * ldc + col0;
#pragma unroll
                for (int bj = 0; bj < 2; ++bj) { const u32x4 g = *(const u32x4*)(zr + bj * HALF);
                    f32x4 v0 = acc[ai][bj][m][0], v1 = acc[ai][bj][m][1];
                    v0[0] *= bflo(g.x); v0[1] *= bfhi(g.x); v0[2] *= bflo(g.y); v0[3] *= bfhi(g.y);
                    v1[0] *= bflo(g.z); v1[1] *= bfhi(g.z); v1[2] *= bflo(g.w); v1[3] *= bfhi(g.w);
                    u32x4 w; w.x = cvt_pk_bf16(v0[0], v0[1]); w.y = cvt_pk_bf16(v0[2], v0[3]); w.z = cvt_pk_bf16(v1[0], v1[1]); w.w = cvt_pk_bf16(v1[2], v1[3]);
                    *(u32x4*)(rowp + bj * HALF) = w; }
                if (m == 3) __builtin_amdgcn_sched_barrier(0); }
    }
};

struct EpiStat {
    static constexpr bool PERM = true, AFTER_DRAIN = false, HOOK = false;
    bf16_t* O; int ldc; float* stats; int hook_t0, hook_t1;
    __device__ __forceinline__ void hook(f32x4 (&acc)[2][2][4][2], const Unit& u, int t, int wr, int wc, int fr, int fq) const {}
    __device__ __forceinline__ void operator()(const f32x4 (&acc)[2][2][4][2], const Unit& u, int wr, int wc, int fr, int fq) const {
        const int row0 = u.pm * BM + wr * 64 + fr; const int col0 = u.pn * BM + wc * 32 + 8 * fq;
#pragma unroll
        for (int ai = 0; ai < 2; ++ai)
#pragma unroll
            for (int m = 0; m < 4; ++m) { const size_t rr = (size_t)(row0 + ai * HALF + m * 16); bf16_t* rowp = O + rr * ldc + col0; float s = 0.f;
#pragma unroll
                for (int bj = 0; bj < 2; ++bj) { const f32x4 v0 = acc[ai][bj][m][0], v1 = acc[ai][bj][m][1];
                    s += (v0[0] * v0[0] + v0[1] * v0[1]) + (v0[2] * v0[2] + v0[3] * v0[3]) + (v1[0] * v1[0] + v1[1] * v1[1]) + (v1[2] * v1[2] + v1[3] * v1[3]);
                    u32x4 w; w.x = cvt_pk_bf16(v0[0], v0[1]); w.y = cvt_pk_bf16(v0[2], v0[3]); w.z = cvt_pk_bf16(v1[0], v1[1]); w.w = cvt_pk_bf16(v1[2], v1[3]);
                    *(u32x4*)(rowp + bj * HALF) = w; }
                s += __shfl_xor(s, 16); s += __shfl_xor(s, 32);
                if (fq == 0) stats[(rr * 8 + u.pn) * 4 + wc] = s; }
    }
};

struct EpiSwi {
    static constexpr bool PERM = true, AFTER_DRAIN = false, HOOK = false;
    bf16_t* O; int ldc; int hook_t0, hook_t1;
    __device__ __forceinline__ void hook(f32x4 (&acc)[2][2][4][2], const Unit& u, int t, int wr, int wc, int fr, int fq) const {}
    __device__ __forceinline__ void operator()(const f32x4 (&acc)[2][2][4][2], const Unit& u, int wr, int wc, int fr, int fq) const {
        const int row0 = u.pm * BM + wr * 64 + fr; const int col0 = u.pn * HALF + wc * 32 + 8 * fq;
#pragma unroll
        for (int ai = 0; ai < 2; ++ai)
#pragma unroll
            for (int m = 0; m < 4; ++m) { bf16_t* rowp = O + (size_t)(row0 + ai * HALF + m * 16) * ldc + col0;
                f32x4 a0 = acc[ai][0][m][0], a1 = acc[ai][0][m][1]; const f32x4 g0 = acc[ai][1][m][0], g1 = acc[ai][1][m][1];
#pragma unroll
                for (int k = 0; k < 4; ++k) { a0[k] = a0[k] * g0[k] * sigm(g0[k]); a1[k] = a1[k] * g1[k] * sigm(g1[k]); }
                u32x4 w; w.x = cvt_pk_bf16(a0[0], a0[1]); w.y = cvt_pk_bf16(a0[2], a0[3]); w.z = cvt_pk_bf16(a1[0], a1[1]); w.w = cvt_pk_bf16(a1[2], a1[3]);
                *(u32x4*)rowp = w; }
    }
};

template <class Epi, class Sched, bool ALIGN_EPI = false, bool SP2 = false>
__device__ __forceinline__ void gemm_phase(PG8_LAS unsigned char* lds, const Gemm g, const Sched& S, const Epi& E) {
    int tid_ = threadIdx.x; asm volatile("" : "+v"(tid_));
    const int tid = tid_, wid = __builtin_amdgcn_readfirstlane(tid >> 6), lane = tid & 63, wr = wid >> 2, wc = wid & 3, fr = lane & 15, fq = lane >> 4;
    const int K = g.K, nt = K / BK, LD = g.ld ? g.ld : K;
    unsigned voffA[2], voffB[2];
#pragma unroll
    for (int i = 0; i < 2; ++i) { int R, C; stage_rc(tid * 16 + i * 8192, R, C); const int Rb = Epi::PERM ? ((R & ~31) + perm32(R & 31)) : R;
        voffA[i] = (unsigned)(R * LD + C) * 2u; voffB[i] = (unsigned)(Rb * LD + C) * 2u; }
    const size_t kstep = (size_t)(BK * 2);
    const size_t hstep = (size_t)HALF * LD * 2;
    const size_t tstep = 2 * hstep;
    const unsigned ldsw = (unsigned)wid * 1024u;
    const int aoff = lds_byte(wr * 64 + fr, fq * 8), boff = lds_byte(wc * 32 + fr, fq * 8);
#define PG8_SA(b, h) (((b) * 2 + (h)) * HTB)
#define PG8_SB(b, h) ((4 + (b) * 2 + (h)) * HTB)
#define PG8_STAGE(bufoff, gbase, voff) do { _Pragma("unroll") for (int _i = 0; _i < 2; ++_i) \
        __builtin_amdgcn_global_load_lds((const unsigned*)((const char*)(gbase) + (voff)[_i]), (PG8_LAS unsigned*)(lds + (bufoff) + ldsw + _i * 8192), 16, 0, 0); } while (0)
#define PG8_LDA(dst, b, h) do { _Pragma("unroll") for (int m = 0; m < 4; ++m) _Pragma("unroll") for (int k = 0; k < 2; ++k) dst[m][k] = *(const PG8_LAS bf16x8*)(lds + PG8_SA(b, h) + aoff + m * 2048 + k * 1024); } while (0)
#define PG8_LDB(dst, b, h) do { _Pragma("unroll") for (int n = 0; n < 2; ++n) _Pragma("unroll") for (int k = 0; k < 2; ++k) dst[n][k] = *(const PG8_LAS bf16x8*)(lds + PG8_SB(b, h) + boff + n * 2048 + k * 1024); } while (0)
#define PG8_MMA(ai, bj, At, Bt) do { __builtin_amdgcn_s_setprio(1); _Pragma("unroll") for (int m = 0; m < 4; ++m) _Pragma("unroll") for (int n = 0; n < 2; ++n) _Pragma("unroll") for (int k = 0; k < 2; ++k) \
        acc[ai][bj][m][n] = __builtin_amdgcn_mfma_f32_16x16x32_bf16(Bt[n][k], At[m][k], acc[ai][bj][m][n], 0, 0, 0); __builtin_amdgcn_s_setprio(0); } while (0)
#define PG8_WAIT_V(n) asm volatile("s_waitcnt vmcnt(" #n ")" ::: "memory")
#define PG8_WAIT_L(n) asm volatile("s_waitcnt lgkmcnt(" #n ")" ::: "memory")
#define PG8_BAR __builtin_amdgcn_s_barrier()
#define PG8_SCHED __builtin_amdgcn_sched_barrier(0)
    Unit cur, nxt; int ui = 0;
    if (!S.next(0, cur)) return;
    f32x4 acc[2][2][4][2];
#pragma unroll
    for (int a = 0; a < 2; ++a)
#pragma unroll
        for (int b = 0; b < 2; ++b)
#pragma unroll
            for (int m = 0; m < 4; ++m)
#pragma unroll
                for (int n = 0; n < 2; ++n) acc[a][b][m][n] = (f32x4){0.f, 0.f, 0.f, 0.f};
    bf16x8 At[4][2], B0[2][2], B1[2][2];
    const char* const gA0_ = (const char*)g.A; const char* const gA1_ = (const char*)g.A1; const char* const gA2_ = (const char*)g.A2;
    const char* const gB0_ = (const char*)g.Bt; const char* const gB1_ = (const char*)g.Bt1; const char* const gB2_ = (const char*)g.Bt2;
    const int gnMr_ = g.nMr, gks_ = g.kslice;
    { const char* a0 = gA0_; (void)a0; }
#define PG8_ABASE(u) (((u).seg == 0 ? gA0_ : ((u).seg == 1 ? gA1_ : gA2_)) + (size_t)((u).pm % gnMr_) * tstep + (size_t)((u).pm / gnMr_) * gks_ * 2)
#define PG8_BBASE(u) (((u).seg == 0 ? gB0_ : ((u).seg == 1 ? gB1_ : gB2_)) + (size_t)(u).pn * tstep + (size_t)((u).pm / gnMr_) * gks_ * 2)
    const char* cA = PG8_ABASE(cur); const char* cB = PG8_BBASE(cur);
    S.a_ready(cur);
    if constexpr (SP2) {
        PG8_STAGE(PG8_SB(0, 0), cB, voffB); PG8_STAGE(PG8_SB(0, 1), cB + hstep, voffB); PG8_STAGE(PG8_SA(0, 0), cA, voffA); PG8_STAGE(PG8_SA(0, 1), cA + hstep, voffA);
        if (wr == 1) PG8_BAR;
        PG8_WAIT_V(2); PG8_BAR;
        PG8_STAGE(PG8_SB(1, 0), cB + kstep, voffB); PG8_STAGE(PG8_SA(1, 0), cA + kstep, voffA); PG8_STAGE(PG8_SB(1, 1), cB + hstep + kstep, voffB);
        PG8_WAIT_V(6); PG8_BAR;
    } else {
        PG8_STAGE(PG8_SB(0, 0), cB, voffB); PG8_STAGE(PG8_SA(0, 0), cA, voffA); PG8_STAGE(PG8_SB(0, 1), cB + hstep, voffB); PG8_STAGE(PG8_SA(0, 1), cA + hstep, voffA);
        if (wr == 1) PG8_BAR;
        PG8_WAIT_V(4); PG8_BAR;
        PG8_STAGE(PG8_SB(1, 0), cB + kstep, voffB); PG8_STAGE(PG8_SA(1, 0), cA + kstep, voffA); PG8_STAGE(PG8_SB(1, 1), cB + hstep + kstep, voffB);
        PG8_WAIT_V(6); PG8_BAR;
    }
    for (;;) {
        const bool has_next = S.next(ui + 1, nxt);
        const char* nA = has_next ? PG8_ABASE(nxt) : cA; const char* nB = has_next ? PG8_BBASE(nxt) : cB;
        for (int t = 0; t < nt; t += 2) {
            if constexpr (Epi::HOOK) { if (t == E.hook_t0 || t == E.hook_t1) E.hook(acc, cur, t, wr, wc, fr, fq); }
            const bool last = (t == nt - 2);
            const char* a1 = cA + (size_t)(t + 1) * kstep;
            const char* a2 = last ? nA : cA + (size_t)(t + 2) * kstep; const char* b2 = last ? nB : cB + (size_t)(t + 2) * kstep;
            const char* a3 = a2 + kstep; const char* b3 = b2 + kstep;
            if (last && has_next) S.a_ready(nxt);
            if constexpr (SP2) {
            PG8_LDB(B0, 0, 0); PG8_LDB(B1, 0, 1); PG8_SCHED; PG8_LDA(At, 0, 0); PG8_STAGE(PG8_SA(1, 1), a1 + hstep, voffA);
            PG8_WAIT_V(8); PG8_WAIT_L(0); PG8_BAR; PG8_MMA(0, 0, At, B0); PG8_MMA(0, 1, At, B1); PG8_BAR; PG8_SCHED;
            PG8_LDA(At, 0, 1); PG8_STAGE(PG8_SB(0, 0), b2, voffB); PG8_STAGE(PG8_SB(0, 1), b2 + hstep, voffB); PG8_STAGE(PG8_SA(0, 0), a2, voffA);
            PG8_WAIT_V(8); PG8_WAIT_L(0); PG8_BAR; PG8_MMA(1, 0, At, B0); PG8_MMA(1, 1, At, B1); PG8_BAR; PG8_SCHED;
            PG8_LDB(B0, 1, 0); PG8_LDB(B1, 1, 1); PG8_SCHED; PG8_LDA(At, 1, 0); PG8_STAGE(PG8_SA(0, 1), a2 + hstep, voffA);
            PG8_WAIT_V(8); PG8_WAIT_L(0); PG8_BAR; PG8_MMA(0, 0, At, B0); PG8_MMA(0, 1, At, B1); PG8_BAR; PG8_SCHED;
            PG8_LDA(At, 1, 1); PG8_STAGE(PG8_SB(1, 0), b3, voffB); PG8_STAGE(PG8_SB(1, 1), b3 + hstep, voffB); PG8_STAGE(PG8_SA(1, 0), a3, voffA);
            PG8_WAIT_V(8); PG8_WAIT_L(0); PG8_BAR; PG8_MMA(1, 0, At, B0); PG8_MMA(1, 1, At, B1); PG8_BAR; PG8_SCHED;
            } else {
            PG8_LDB(B0, 0, 0); PG8_SCHED; PG8_LDA(At, 0, 0); PG8_STAGE(PG8_SA(1, 1), a1 + hstep, voffA);
            PG8_WAIT_L(8); PG8_BAR; PG8_WAIT_L(0); PG8_MMA(0, 0, At, B0); PG8_BAR; PG8_SCHED;
            PG8_LDB(B1, 0, 1); PG8_STAGE(PG8_SB(0, 0), b2, voffB);
            PG8_BAR; PG8_WAIT_L(0); PG8_MMA(0, 1, At, B1); PG8_BAR;
            PG8_LDA(At, 0, 1); PG8_STAGE(PG8_SA(0, 0), a2, voffA);
            PG8_BAR; PG8_WAIT_L(0); PG8_MMA(1, 0, At, B0); PG8_BAR; PG8_SCHED;
            PG8_STAGE(PG8_SB(0, 1), b2 + hstep, voffB);
            PG8_WAIT_V(6); PG8_BAR; PG8_MMA(1, 1, At, B1); PG8_BAR;
            PG8_LDB(B0, 1, 0); PG8_SCHED; PG8_LDA(At, 1, 0); PG8_STAGE(PG8_SA(0, 1), a2 + hstep, voffA);
            PG8_WAIT_L(8); PG8_BAR; PG8_WAIT_L(0); PG8_MMA(0, 0, At, B0); PG8_BAR; PG8_SCHED;
            PG8_LDB(B1, 1, 1); PG8_STAGE(PG8_SB(1, 0), b3, voffB);
            PG8_BAR; PG8_WAIT_L(0); PG8_MMA(0, 1, At, B1); PG8_BAR;
            PG8_LDA(At, 1, 1); PG8_STAGE(PG8_SA(1, 0), a3, voffA);
            PG8_BAR; PG8_WAIT_L(0); PG8_MMA(1, 0, At, B0); PG8_BAR; PG8_SCHED;
            PG8_STAGE(PG8_SB(1, 1), b3 + hstep, voffB);
            PG8_WAIT_V(6); PG8_BAR; PG8_MMA(1, 1, At, B1); PG8_BAR;
            }
        }
        if constexpr (ALIGN_EPI) { if (wr == 0) PG8_BAR; }
        if constexpr (!Epi::AFTER_DRAIN) { E(acc, cur, wr, wc, fr, fq); S.done(cur); }
        if (!has_next) break;
#pragma unroll
        for (int a = 0; a < 2; ++a)
#pragma unroll
            for (int b = 0; b < 2; ++b)
#pragma unroll
                for (int m = 0; m < 4; ++m)
#pragma unroll
                    for (int n = 0; n < 2; ++n) acc[a][b][m][n] = (f32x4){0.f, 0.f, 0.f, 0.f};
        cur = nxt; cA = nA; cB = nB; ++ui;
        if constexpr (ALIGN_EPI) { if (wr == 1) PG8_BAR; }
    }
    PG8_WAIT_V(0);
    if constexpr (!ALIGN_EPI) { if (wr == 0) PG8_BAR; }
    PG8_BAR;
    if constexpr (Epi::AFTER_DRAIN) { E.fused(acc, cur, wr, wc, fr, fq, lds, wid, lane); S.done(cur); }
#undef PG8_ABASE
#undef PG8_BBASE
#undef PG8_SA
#undef PG8_SB
#undef PG8_STAGE
#undef PG8_LDA
#undef PG8_LDB
#undef PG8_MMA
#undef PG8_WAIT_V
#undef PG8_WAIT_L
#undef PG8_BAR
#undef PG8_SCHED
}
}

#define GAS __attribute__((address_space(1)))
#define LAS __attribute__((address_space(3)))
typedef unsigned short bf16;
typedef unsigned v4u __attribute__((ext_vector_type(4)));
typedef unsigned v2u __attribute__((ext_vector_type(2)));
typedef float f32x4 __attribute__((ext_vector_type(4)));
typedef float f32x16 __attribute__((ext_vector_type(16)));
typedef short bf16x8 __attribute__((ext_vector_type(8)));
typedef short s16x4 __attribute__((ext_vector_type(4)));
typedef short v4i16_t __attribute__((ext_vector_type(4)));
#define MFMA32(a, b, c) __builtin_amdgcn_mfma_f32_32x32x16_bf16((a), (b), (c), 0, 0, 0)
using pg8::ZSW; using pg8::ZRW; using pg8::ZW; using pg8::ZS_MQ; using pg8::ZS_MK; using pg8::ZS_MV; using pg8::ZS_MO; using pg8::ZS_RQ; using pg8::ZS_RK; using pg8::ZS_RV; using pg8::ZS_RG; using pg8::ZS_MISC; using pg8::ZR_DQ; using pg8::ZR_DKV; using pg8::ZR_KR; using pg8::ZR_GM; using pg8::ZR_GA; using pg8::ZR_GR;

constexpr int NWAVES = 8, NTHR = 512;
constexpr int DM = 2048, NBATCH = 8, SEQ = 4096, DSEQ = 64, PAST = 1024, DFF = 5632, DIN = 13384;
constexpr int MP = NBATCH * SEQ, MS = NBATCH * DSEQ, MT = MP + MS;
constexpr float EPS = 1e-6f;
constexpr int YW = 3072;
__device__ __forceinline__ int grp_row0(int g) { return g * 12288; }
__device__ __forceinline__ int grp_rows(int g) { return g < 2 ? 12288 : 8704; }
__device__ __forceinline__ int grp_ck(int g) { return g < 2 ? 12288 : 16896; }
constexpr int GROWS_MAX = 12288, GCK_MAX = 16896;

constexpr size_t MiB = 1u << 20;
constexpr size_t WS_CTL = 0;
constexpr size_t WS_ROPEA = 1 * MiB;
constexpr size_t WS_ROPER = 2 * MiB;
constexpr size_t WS_W = 4 * MiB, W_LAYER = 144 * MiB;
constexpr size_t WO_IN = 0, WO_GU = WO_IN + (size_t)ZW * DM * 2, WO_DOWN = WO_GU + (size_t)2 * DFF * DM * 2, WO_O = WO_DOWN + (size_t)DM * DFF * 2,
                 WO_UP = WO_O + (size_t)DM * DM * 2, WO_UQ = WO_UP + (size_t)DM * YW * 2, WO_UK = WO_UQ + (size_t)1536 * 512 * 2, WO_V = WO_UK + (size_t)1024 * 512 * 2,
                 WO_BIAS = WO_V + (size_t)1024 * 512 * 2, WO_END = WO_BIAS + (size_t)ZW * 4;
static_assert(WO_END <= W_LAYER, "weights per layer");
constexpr size_t WS_XB = WS_W + 2 * W_LAYER;
constexpr size_t WS_G = WS_XB + (size_t)MT * DM * 2;
constexpr size_t GO_ZS = 0, GO_ZS_END = (size_t)MT * ZSW * 2;
constexpr size_t GO_Z = 0, GO_QA = GO_Z + (size_t)GROWS_MAX * ZRW * 2, GO_QN = GO_QA + (size_t)GROWS_MAX * 1536 * 2, GO_CK = GO_QN + (size_t)GROWS_MAX * 512 * 2,
                 GO_KR = GO_CK + (size_t)GCK_MAX * 512 * 2, GO_KN = GO_KR + (size_t)GCK_MAX * 64 * 2, GO_VT = GO_KN + (size_t)GCK_MAX * 1024 * 2, GO_GEND = GO_VT + (size_t)GCK_MAX * 1024 * 2;
static_assert(GO_GEND <= GO_ZS_END, "group buffers overlay Zs");
constexpr size_t GO_Y = GO_ZS_END, GO_END = GO_Y + (size_t)MT * YW * 2;
constexpr size_t GO_ACT = 0, GO_MIX = (size_t)MT * DFF * 2, GO_TP = GO_MIX + (size_t)MT * DM * 2;
static_assert(GO_TP + (size_t)11 * MS * DM * 2 <= GO_END, "overlay");
constexpr size_t WS_END = WS_G + GO_END;
static_assert(WS_END <= (size_t)1024 * MiB, "ws");

constexpr int LDS_BYTES = 147456;
constexpr int MISC_OFF = 131072;

__device__ __forceinline__ float bf2f(unsigned short b) { return __uint_as_float((unsigned)b << 16); }
typedef __bf16 hwbf2 __attribute__((ext_vector_type(2)));
typedef float hwf2 __attribute__((ext_vector_type(2)));
__device__ __forceinline__ unsigned pk2(float lo, float hi) { hwf2 v = {lo, hi}; return __builtin_bit_cast(unsigned, __builtin_convertvector(v, hwbf2)); }
__device__ __forceinline__ unsigned f2bf(float f) { return pk2(f, 0.f) & 0xffffu; }
__device__ __forceinline__ float blo(unsigned w) { return __uint_as_float(w << 16); }
__device__ __forceinline__ float bhi(unsigned w) { return __uint_as_float(w & 0xffff0000u); }
template <int CTRL> __device__ __forceinline__ float dppf(float v) { return __int_as_float(__builtin_amdgcn_update_dpp(0, __float_as_int(v), CTRL, 0xf, 0xf, true)); }
__device__ __forceinline__ float wave_sum(float v) {
    v += dppf<0xB1>(v);
    v += dppf<0x4E>(v);
    v += dppf<0x141>(v);
    v += dppf<0x140>(v);
    v += __shfl_xor(v, 16); v += __shfl_xor(v, 32);
    return v;
}
template <int CTRL> __device__ __forceinline__ float dppk(float old, float v) { return __int_as_float(__builtin_amdgcn_update_dpp(__float_as_int(old), __float_as_int(v), CTRL, 0xf, 0xf, false)); }
__device__ __forceinline__ float rdlane(float v, int l) { return __int_as_float(__builtin_amdgcn_readlane(__float_as_int(v), l)); }
__device__ __forceinline__ int crow(int i, int hh) { return (i & 3) + 8 * (i >> 2) + 4 * hh; }
__device__ __forceinline__ bf16x8 pack8(float a0, float a1, float a2, float a3, float a4, float a5, float a6, float a7) {
    v4u p; p.x = pk2(a0, a1); p.y = pk2(a2, a3); p.z = pk2(a4, a5); p.w = pk2(a6, a7); return __builtin_bit_cast(bf16x8, p);
}
__device__ __forceinline__ s16x4 trrd(const LAS unsigned char* p) { return __builtin_bit_cast(s16x4, __builtin_amdgcn_ds_read_tr16_b64_v4i16((LAS v4i16_t*)p)); }
__device__ __forceinline__ bf16x8 cat4(s16x4 lo, s16x4 hi) { return __builtin_shufflevector(lo, hi, 0, 1, 2, 3, 4, 5, 6, 7); }

struct Args { const float* in[26]; float* out; unsigned char* ws; int ph_lo, ph_hi; };

constexpr size_t O_YP = 0, O_YS = O_YP + (size_t)MP * DM, O_PCKV = O_YS + (size_t)MS * DM, O_PKR = O_PCKV + (size_t)2 * MP * 512, O_PC = O_PKR + (size_t)2 * MP * 64,
                 O_PN = O_PC + (size_t)2 * 8 * 4 * 256 * 128, O_PM = O_PN + (size_t)2 * 8 * 4 * 128, O_PR = O_PM + 64, O_SCKV = O_PR + (size_t)2 * 8 * 4 * 128 * 256,
                 O_SKR = O_SCKV + (size_t)2 * MS * 512, O_SC = O_SKR + (size_t)2 * MS * 64, O_SN = O_SC + (size_t)2 * 8 * 4 * 256 * 128, O_SM = O_SN + (size_t)2 * 8 * 4 * 128,
                 O_SR = O_SM + 64, O_END = O_SR + (size_t)2 * 8 * 4 * 128 * 256;

__device__ __forceinline__ int zsrc(int n) {
    if (n < 3072) return n;
    if (n < 6144) return n - 3072 + 4168;
    if (n < 6400) { const int j = n - 6144; return j < 8 ? 3072 + j : -1; }
    const int m = n - 6400;
    if (m < 1024) return 3080 + m;
    if (m < 1280) { const int j = m - 1024; return j < 64 ? 4104 + j : -1; }
    return 7240 + (m - 1280);
}
__device__ __forceinline__ int srccol(int mode, int n) {
    switch (mode) {
        case 0: return zsrc(n);
        case 1: return ((n & 255) < 128) ? 128 * (n >> 8) + (n & 127) : DFF + 128 * (n >> 8) + (n & 127);
        case 3: return (n >> 7) * 256 + (n & 127);
        case 4: return (n >> 7) * 256 + 128 + (n & 127);
        default: return n;
    }
}
__device__ __forceinline__ void transpose_item(const float* W, int Nsrc, bf16* WT, int ldd, int koff, int mode, int nblk, LAS float* scr, int item, int lane) {
    const int kb = item / nblk, nb = item % nblk, k0 = 64 * kb, n0 = 32 * nb;
    const int sc = srccol(mode, n0 + (lane & 31));
    float wv[32];
#pragma unroll
    for (int i = 0; i < 32; ++i) { const int kk = 2 * i + (lane >> 5); wv[i] = sc >= 0 ? __builtin_nontemporal_load(W + (size_t)(k0 + kk) * Nsrc + sc) : 0.f; }
#pragma unroll
    for (int i = 0; i < 32; ++i) { const int kk = 2 * i + (lane >> 5); scr[kk * 33 + (lane & 31)] = wv[i]; }
    asm volatile("s_waitcnt lgkmcnt(0)" ::: "memory");
    const int c = lane & 7;
#pragma unroll
    for (int j = 0; j < 4; ++j) { const int n = (lane >> 3) + 8 * j; const LAS float* s = scr + (8 * c) * 33 + n;
        v4u o; o.x = pk2(s[0 * 33], s[1 * 33]); o.y = pk2(s[2 * 33], s[3 * 33]); o.z = pk2(s[4 * 33], s[5 * 33]); o.w = pk2(s[6 * 33], s[7 * 33]);
        *(v4u*)(WT + (size_t)(n0 + n) * ldd + koff + k0 + 8 * c) = o; }
    asm volatile("s_waitcnt lgkmcnt(0)" ::: "memory");
}
__device__ __forceinline__ void rms_row2_to_bf16(const float* xa, const float* xb, const float* g, bf16* oa, bf16* ob, int lane) {
    f32x4 va[8], vb[8]; float sa = 0.f, sb = 0.f;
#pragma unroll
    for (int j = 0; j < 8; ++j) { va[j] = __builtin_nontemporal_load((const f32x4*)(xa + 4 * lane + 256 * j)); vb[j] = __builtin_nontemporal_load((const f32x4*)(xb + 4 * lane + 256 * j)); }
#pragma unroll
    for (int j = 0; j < 8; ++j) { sa += (va[j].x * va[j].x + va[j].y * va[j].y) + (va[j].z * va[j].z + va[j].w * va[j].w); sb += (vb[j].x * vb[j].x + vb[j].y * vb[j].y) + (vb[j].z * vb[j].z + vb[j].w * vb[j].w); }
    const float ra = rsqrtf(wave_sum(sa) * (1.f / DM) + EPS), rb = rsqrtf(wave_sum(sb) * (1.f / DM) + EPS);
#pragma unroll
    for (int j = 0; j < 8; ++j) { const f32x4 gg = *(const f32x4*)(g + 4 * lane + 256 * j);
        v2u o; o.x = pk2(va[j].x * ra * gg.x, va[j].y * ra * gg.y); o.y = pk2(va[j].z * ra * gg.z, va[j].w * ra * gg.w); *(v2u*)(oa + 4 * lane + 256 * j) = o;
        v2u q; q.x = pk2(vb[j].x * rb * gg.x, vb[j].y * rb * gg.y); q.y = pk2(vb[j].z * rb * gg.z, vb[j].w * rb * gg.w); *(v2u*)(ob + 4 * lane + 256 * j) = q; }
}
__device__ __forceinline__ void rms_row_to_bf16(const float* xrow, const float* g, bf16* orow, int lane) {
    f32x4 v[8]; float s = 0.f;
#pragma unroll
    for (int j = 0; j < 8; ++j) { v[j] = __builtin_nontemporal_load((const f32x4*)(xrow + 4 * lane + 256 * j)); s += (v[j].x * v[j].x + v[j].y * v[j].y) + (v[j].z * v[j].z + v[j].w * v[j].w); }
    const float r = rsqrtf(wave_sum(s) * (1.f / DM) + EPS);
#pragma unroll
    for (int j = 0; j < 8; ++j) { const f32x4 gg = *(const f32x4*)(g + 4 * lane + 256 * j);
        v2u o; o.x = pk2(v[j].x * r * gg.x, v[j].y * r * gg.y); o.y = pk2(v[j].z * r * gg.z, v[j].w * r * gg.w); *(v2u*)(orow + 4 * lane + 256 * j) = o; }
}

struct Ctx {
    LAS unsigned char* lds; int tid, lane, wave, G, bid;
    float* out; unsigned char* ws;
};
__device__ __forceinline__ const float* cin(const Ctx& C, int i) {
    const LAS unsigned* p = (const LAS unsigned*)(C.lds + MISC_OFF + 64 + 8 * i);
    const unsigned lo = __builtin_amdgcn_readfirstlane(p[0]), hi = __builtin_amdgcn_readfirstlane(p[1]);
    return (const float*)(((unsigned long long)hi << 32) | lo);
}
#define WPTR(layer, off) ((bf16*)(C.ws + WS_W + (size_t)(layer) * W_LAYER + (off)))
#define GPTR(off) ((bf16*)(C.ws + WS_G + (off)))

constexpr int W_I_IN = (DM / 64) * (ZW / 32), W_I_GU = (DM / 64) * (2 * DFF / 32), W_I_DN = (DFF / 64) * (DM / 32), W_I_O = (DM / 64) * (DM / 32), W_I_UP = (1024 / 64) * (DM / 32),
              W_I_UQ = (512 / 64) * (1536 / 32), W_I_UK = (512 / 64) * (1024 / 32);
constexpr int W_NITEMS = W_I_IN + W_I_GU + W_I_DN + W_I_O + 3 * W_I_UP + W_I_UQ + 2 * W_I_UK;
__device__ __forceinline__ void weight_item(Ctx& C, int layer, int it, LAS float* scr) {
    int r = it;
    if (r < W_I_IN) { transpose_item(cin(C, 9) + (size_t)layer * DM * DIN, DIN, WPTR(layer, WO_IN), DM, 0, 0, ZW / 32, scr, r, C.lane); return; } r -= W_I_IN;
    if (r < W_I_GU) { transpose_item(cin(C, 23) + (size_t)layer * DM * 2 * DFF, 2 * DFF, WPTR(layer, WO_GU), DM, 0, 1, 2 * DFF / 32, scr, r, C.lane); return; } r -= W_I_GU;
    if (r < W_I_DN) { transpose_item(cin(C, 24) + (size_t)layer * DFF * DM, DM, WPTR(layer, WO_DOWN), DFF, 0, 2, DM / 32, scr, r, C.lane); return; } r -= W_I_DN;
    if (r < W_I_O) { transpose_item(cin(C, 20) + (size_t)layer * DM * DM, DM, WPTR(layer, WO_O), DM, 0, 2, DM / 32, scr, r, C.lane); return; } r -= W_I_O;
    if (r < W_I_UP) { transpose_item(cin(C, 12) + (size_t)layer * 1024 * DM, DM, WPTR(layer, WO_UP), YW, 0, 2, DM / 32, scr, r, C.lane); return; } r -= W_I_UP;
    if (r < W_I_UP) { transpose_item(cin(C, 17) + (size_t)layer * 1024 * DM, DM, WPTR(layer, WO_UP), YW, 1024, 2, DM / 32, scr, r, C.lane); return; } r -= W_I_UP;
    if (r < W_I_UP) { transpose_item(cin(C, 19) + (size_t)layer * 1024 * DM, DM, WPTR(layer, WO_UP), YW, 2048, 2, DM / 32, scr, r, C.lane); return; } r -= W_I_UP;
    if (r < W_I_UQ) { transpose_item(cin(C, 14) + (size_t)layer * 512 * 1536, 1536, WPTR(layer, WO_UQ), 512, 0, 2, 1536 / 32, scr, r, C.lane); return; } r -= W_I_UQ;
    if (r < W_I_UK) { transpose_item(cin(C, 16) + (size_t)layer * 512 * 2048, 2048, WPTR(layer, WO_UK), 512, 0, 3, 1024 / 32, scr, r, C.lane); return; } r -= W_I_UK;
    transpose_item(cin(C, 16) + (size_t)layer * 512 * 2048, 2048, WPTR(layer, WO_V), 512, 0, 4, 1024 / 32, scr, r, C.lane);
}

__device__ __forceinline__ void p0_prologue(Ctx& C) {
    asm volatile("" : "+v"(C.lane)); C.tid = C.wave * 64 + C.lane;
    LAS float* scr = (LAS float*)(C.lds + C.wave * 16384);
    int gw = C.bid * NWAVES + C.wave; const int NGW = C.G * NWAVES;
    for (int it = gw; it < W_I_IN + W_I_UQ + 2 * W_I_UK; it += NGW) weight_item(C, 0, it < W_I_IN ? it : it - W_I_IN + (W_NITEMS - W_I_UQ - 2 * W_I_UK), scr);
    for (int layer = 0; layer < 2; ++layer) {
        float* bz = (float*)(C.ws + WS_W + (size_t)layer * W_LAYER + WO_BIAS);
        for (int n = C.bid * NTHR + C.tid; n < ZW; n += C.G * NTHR) { const int s = zsrc(n); bz[n] = s >= 0 ? cin(C, 10)[(size_t)layer * DIN + s] : 0.f; }
    }
    {
        float* ca = (float*)(C.ws + WS_ROPEA); float* sa = ca + 4096 * 32; float* cr = (float*)(C.ws + WS_ROPER); float* sr = cr + 4096 * 64;
        for (int e = C.bid * NTHR + C.tid; e < 4096 * 96; e += C.G * NTHR) {
            int pos, i, d; float* cp; float* sp;
            if (e < 4096 * 32) { pos = e >> 5; i = e & 31; d = 64; cp = ca + e; sp = sa + e; } else { const int e2 = e - 4096 * 32; pos = e2 >> 6; i = e2 & 63; d = 128; cp = cr + e2; sp = sr + e2; }
            const float inv = 1.0f / powf(10000.0f, (float)(2 * i) / (float)d);
            const float ang = (float)pos * inv;
            const double a = (double)ang; const double k = rint(a * 0.15915494309189535); const double red = a - k * 6.283185307179586;
            const float rf = (float)red;
            *cp = __cosf(rf); *sp = __sinf(rf);
        }
    }
    bf16* XB = (bf16*)(C.ws + WS_XB);
    for (int m = gw; m < MT; m += 2 * NGW) {
        const int m2 = m + NGW; const bool has2 = m2 < MT;
        const float* xr = m < MP ? cin(C, 0) + (size_t)m * DM : cin(C, 1) + (size_t)(m - MP) * DM;
        const float* xr2 = has2 ? (m2 < MP ? cin(C, 0) + (size_t)m2 * DM : cin(C, 1) + (size_t)(m2 - MP) * DM) : xr;
        rms_row2_to_bf16(xr, xr2, cin(C, 8), XB + (size_t)m * DM, XB + (size_t)(has2 ? m2 : m) * DM, C.lane); }
}

__device__ __forceinline__ void pe_phase(Ctx& C, int layer, int g) {
    asm volatile("" : "+v"(C.lane)); C.tid = C.wave * 64 + C.lane;
    const int gw = C.bid * NWAVES + C.wave, NGW = C.G * NWAVES, lane = C.lane;
    const bf16* Z = GPTR(GO_Z); bf16* QN = GPTR(GO_QN); bf16* CK = GPTR(GO_CK); bf16* KR = GPTR(GO_KR);
    const float* gqa = cin(C, 13) + layer * 512; const float* gkv = cin(C, 15) + layer * 512;
    const float* ca = (const float*)(C.ws + WS_ROPEA); const float* sa = ca + 4096 * 32;
    const int rows = grp_rows(g), r0 = grp_row0(g);
    for (int lr = gw; lr < rows; lr += NGW) {
        const int m = r0 + lr; const bool smp = m >= MP;
        const int b = smp ? (m - MP) >> 6 : m >> 12, s = smp ? (m - MP) & 63 : m & 4095, pos = smp ? PAST + s : s;
        const int ckrow = smp ? 16384 + (m - MP) : lr;
        const bf16* zr = Z + (size_t)lr * ZRW;
        {
            const v4u w = *(const v4u*)(zr + ZR_DQ + 8 * lane);
            float v[8] = {blo(w.x), bhi(w.x), blo(w.y), bhi(w.y), blo(w.z), bhi(w.z), blo(w.w), bhi(w.w)}; float ss = 0.f;
#pragma unroll
            for (int k = 0; k < 8; ++k) ss += v[k] * v[k];
            const float r = rsqrtf(wave_sum(ss) * (1.f / 512.f) + EPS);
            const f32x4 g0 = *(const f32x4*)(gqa + 8 * lane), g1 = *(const f32x4*)(gqa + 8 * lane + 4);
            v4u o; o.x = pk2(v[0] * r * g0.x, v[1] * r * g0.y); o.y = pk2(v[2] * r * g0.z, v[3] * r * g0.w); o.z = pk2(v[4] * r * g1.x, v[5] * r * g1.y); o.w = pk2(v[6] * r * g1.z, v[7] * r * g1.w);
            *(v4u*)(QN + (size_t)lr * 512 + 8 * lane) = o;
        }
        {
            const v4u w = *(const v4u*)(zr + ZR_DKV + 8 * lane);
            float v[8] = {blo(w.x), bhi(w.x), blo(w.y), bhi(w.y), blo(w.z), bhi(w.z), blo(w.w), bhi(w.w)}; float ss = 0.f;
#pragma unroll
            for (int k = 0; k < 8; ++k) ss += v[k] * v[k];
            const float r = rsqrtf(wave_sum(ss) * (1.f / 512.f) + EPS);
            const f32x4 g0 = *(const f32x4*)(gkv + 8 * lane), g1 = *(const f32x4*)(gkv + 8 * lane + 4);
            f32x4 o0 = {v[0] * r * g0.x, v[1] * r * g0.y, v[2] * r * g0.z, v[3] * r * g0.w}, o1 = {v[4] * r * g1.x, v[5] * r * g1.y, v[6] * r * g1.z, v[7] * r * g1.w};
            float* op = smp ? C.out + O_SCKV + ((size_t)(layer * 8 + b) * DSEQ + s) * 512 : C.out + O_PCKV + ((size_t)(layer * 8 + b) * SEQ + s) * 512;
            __builtin_nontemporal_store(o0, (f32x4*)(op + 8 * lane)); __builtin_nontemporal_store(o1, (f32x4*)(op + 8 * lane + 4));
            v4u o; o.x = pk2(o0.x, o0.y); o.y = pk2(o0.z, o0.w); o.z = pk2(o1.x, o1.y); o.w = pk2(o1.z, o1.w);
            *(v4u*)(CK + (size_t)ckrow * 512 + 8 * lane) = o;
        }
        if (lane < 32) {
            const float x1 = bf2f(zr[ZR_KR + lane]), x2 = bf2f(zr[ZR_KR + 32 + lane]);
            const float c = ca[pos * 32 + lane], sn = sa[pos * 32 + lane];
            const float o1 = x1 * c - x2 * sn, o2 = x1 * sn + x2 * c;
            float* op = smp ? C.out + O_SKR + ((size_t)(layer * 8 + b) * DSEQ + s) * 64 : C.out + O_PKR + ((size_t)(layer * 8 + b) * SEQ + s) * 64;
            op[lane] = o1; op[32 + lane] = o2;
            KR[(size_t)ckrow * 64 + lane] = (bf16)f2bf(o1); KR[(size_t)ckrow * 64 + 32 + lane] = (bf16)f2bf(o2);
        }
    }
    if (g == 2) {
        const float* cc = cin(C, 2) + (size_t)layer * 8 * PAST * 512; const float* ck = cin(C, 3) + (size_t)layer * 8 * PAST * 64;
        { const size_t st = (size_t)C.G * NTHR, n = (size_t)8192 * 128;
          for (size_t e = (size_t)C.bid * NTHR + C.tid; e < n; e += 4 * st) { f32x4 v[4];
#pragma unroll
              for (int u = 0; u < 4; ++u) if (e + u * st < n) v[u] = __builtin_nontemporal_load((const f32x4*)(cc + (e + u * st) * 4));
#pragma unroll
              for (int u = 0; u < 4; ++u) if (e + u * st < n) { v2u o; o.x = pk2(v[u].x, v[u].y); o.y = pk2(v[u].z, v[u].w); *(v2u*)(CK + (size_t)8192 * 512 + (e + u * st) * 4) = o; } } }
        for (size_t e = (size_t)C.bid * NTHR + C.tid; e < (size_t)8192 * 16; e += (size_t)C.G * NTHR) { const f32x4 v = __builtin_nontemporal_load((const f32x4*)(ck + e * 4)); v2u o; o.x = pk2(v.x, v.y); o.y = pk2(v.z, v.w); *(v2u*)(KR + (size_t)8192 * 64 + e * 4) = o; }
    }
}

__device__ __forceinline__ void px_phase(Ctx& C, const bf16* T, const bf16* TP, int nsplit, const float* gpost, const float* gnext, bool first_layer_input) {
    asm volatile("" : "+v"(C.lane)); C.tid = C.wave * 64 + C.lane;
    const int gw = C.bid * NWAVES + C.wave, NGW = C.G * NWAVES, lane = C.lane;
    bf16* XB = (bf16*)(C.ws + WS_XB);
    int m0 = gw;
    if (((MP / NGW) & 1) == 0 && (MP % NGW) == 0) {
        for (; m0 < MP; m0 += 2 * NGW) {
            f32x4 t[2][8], x[2][8];
#pragma unroll
            for (int rr = 0; rr < 2; ++rr) { const int m = m0 + rr * NGW;
                const float* xr = first_layer_input ? cin(C, 0) + (size_t)m * DM : C.out + (size_t)m * DM;
#pragma unroll
                for (int j = 0; j < 8; ++j) { const v2u w = __builtin_nontemporal_load((const v2u*)(T + (size_t)m * DM + 4 * lane + 256 * j)); t[rr][j] = (f32x4){blo(w.x), bhi(w.x), blo(w.y), bhi(w.y)};
                    x[rr][j] = __builtin_nontemporal_load((const f32x4*)(xr + 4 * lane + 256 * j)); } }
#pragma unroll
            for (int rr = 0; rr < 2; ++rr) { const int m = m0 + rr * NGW; float* xo = C.out + (size_t)m * DM; float ts = 0.f;
#pragma unroll
                for (int j = 0; j < 8; ++j) ts += (t[rr][j].x * t[rr][j].x + t[rr][j].y * t[rr][j].y) + (t[rr][j].z * t[rr][j].z + t[rr][j].w * t[rr][j].w);
                const float r = rsqrtf(wave_sum(ts) * (1.f / DM) + EPS); float ss = 0.f;
#pragma unroll
                for (int j = 0; j < 8; ++j) { const int idx = 4 * lane + 256 * j; const f32x4 gg = *(const f32x4*)(gpost + idx); f32x4 v;
                    v.x = x[rr][j].x + t[rr][j].x * r * gg.x; v.y = x[rr][j].y + t[rr][j].y * r * gg.y; v.z = x[rr][j].z + t[rr][j].z * r * gg.z; v.w = x[rr][j].w + t[rr][j].w * r * gg.w;
                    __builtin_nontemporal_store(v, (f32x4*)(xo + idx)); t[rr][j] = v; ss += (v.x * v.x + v.y * v.y) + (v.z * v.z + v.w * v.w); }
                if (gnext) { const float r2 = rsqrtf(wave_sum(ss) * (1.f / DM) + EPS);
#pragma unroll
                    for (int j = 0; j < 8; ++j) { const int idx = 4 * lane + 256 * j; const f32x4 gg = *(const f32x4*)(gnext + idx);
                        v2u o; o.x = pk2(t[rr][j].x * r2 * gg.x, t[rr][j].y * r2 * gg.y); o.y = pk2(t[rr][j].z * r2 * gg.z, t[rr][j].w * r2 * gg.w); *(v2u*)(XB + (size_t)m * DM + idx) = o; } } }
        }
    }
    for (int m = m0; m < MT; m += NGW) {
        const float* xr = first_layer_input ? (m < MP ? cin(C, 0) + (size_t)m * DM : cin(C, 1) + (size_t)(m - MP) * DM) : C.out + (size_t)m * DM;
        float* xo = C.out + (size_t)m * DM;
        f32x4 t[8]; float ts = 0.f;
        if (m < MP) {
#pragma unroll
            for (int j = 0; j < 8; ++j) { const v2u w = __builtin_nontemporal_load((const v2u*)(T + (size_t)m * DM + 4 * lane + 256 * j)); t[j] = (f32x4){blo(w.x), bhi(w.x), blo(w.y), bhi(w.y)}; }
        } else {
#pragma unroll
            for (int j = 0; j < 8; ++j) t[j] = (f32x4){0.f, 0.f, 0.f, 0.f};
            for (int s = 0; s < nsplit; ++s) {
#pragma unroll
                for (int j = 0; j < 8; ++j) { const v2u w = *(const v2u*)(TP + ((size_t)s * MS + (m - MP)) * DM + 4 * lane + 256 * j); t[j].x += blo(w.x); t[j].y += bhi(w.x); t[j].z += blo(w.y); t[j].w += bhi(w.y); }
            }
        }
#pragma unroll
        for (int j = 0; j < 8; ++j) ts += (t[j].x * t[j].x + t[j].y * t[j].y) + (t[j].z * t[j].z + t[j].w * t[j].w);
        const float r = rsqrtf(wave_sum(ts) * (1.f / DM) + EPS);
        float ss = 0.f;
#pragma unroll
        for (int j = 0; j < 8; ++j) { const int idx = 4 * lane + 256 * j; const f32x4 x = __builtin_nontemporal_load((const f32x4*)(xr + idx)); const f32x4 gg = *(const f32x4*)(gpost + idx);
            t[j].x = x.x + t[j].x * r * gg.x; t[j].y = x.y + t[j].y * r * gg.y; t[j].z = x.z + t[j].z * r * gg.z; t[j].w = x.w + t[j].w * r * gg.w;
            __builtin_nontemporal_store(t[j], (f32x4*)(xo + idx)); ss += (t[j].x * t[j].x + t[j].y * t[j].y) + (t[j].z * t[j].z + t[j].w * t[j].w); }
        if (gnext) {
            const float r2 = rsqrtf(wave_sum(ss) * (1.f / DM) + EPS);
#pragma unroll
            for (int j = 0; j < 8; ++j) { const int idx = 4 * lane + 256 * j; const f32x4 gg = *(const f32x4*)(gnext + idx);
                v2u o; o.x = pk2(t[j].x * r2 * gg.x, t[j].y * r2 * gg.y); o.y = pk2(t[j].z * r2 * gg.z, t[j].w * r2 * gg.w); *(v2u*)(XB + (size_t)m * DM + idx) = o; }
        }
    }
}

constexpr int AT_KROW = 400, AT_VROW = 136, AT_VS = 64 * AT_KROW, AT_BUF = AT_VS + 128 * AT_VROW;
static_assert(AT_BUF % 16 == 0 && 2 * AT_BUF <= 131072, "attention LDS");
__device__ __forceinline__ void attn_unit(Ctx& C, int g, bool sample, int bsel, int hd, int qt) {
    int lane_ = C.lane; asm volatile("" : "+v"(lane_)); asm volatile("" : "+s"(C.ws), "+s"(C.out));
    const int w = C.wave, lane = lane_, tid = w * 64 + lane, r = lane & 31, hh = lane >> 5;
    LAS unsigned char* lds = C.lds;
    const bf16* QA = GPTR(GO_QA); const bf16* KN = GPTR(GO_KN); const bf16* KR = GPTR(GO_KR); const bf16* VT = GPTR(GO_VT); bf16* Y = GPTR(GO_Y);
    const int ldv = grp_ck(g);
    const int qrow0 = sample ? 8192 + bsel * 64 : bsel * 4096 + qt * 256;
    const int pos0 = sample ? PAST : qt * 256;
    const int ntiles = sample ? 17 : 4 * qt + 4;
    const bool wact = sample ? (w < 2) : true;
    const int jlim = sample ? 16 : 4 * qt + (w >> 1);
    v4u kreg[3], vreg[2];
#define AT_TROW(j) (sample ? ((j) < 16 ? 8192 + bsel * 1024 + 64 * (j) : 16384 + bsel * 64) : bsel * 4096 + 64 * (j))
#define AT_LOAD(j) do { const int trow_ = AT_TROW(j); \
        _Pragma("unroll") for (int i_ = 0; i_ < 3; ++i_) { const int c_ = tid + 512 * i_, key_ = c_ / 24, ch_ = c_ - 24 * key_; \
            kreg[i_] = ch_ < 16 ? *(const v4u*)((const char*)(KN + (size_t)trow_ * 1024 + hd * 128) + (unsigned)(key_ * 1024 + 8 * ch_) * 2u) : *(const v4u*)((const char*)(KR + (size_t)trow_ * 64) + (unsigned)(key_ * 64 + 8 * (ch_ - 16)) * 2u); } \
        _Pragma("unroll") for (int i_ = 0; i_ < 2; ++i_) { const int c_ = tid + 512 * i_, dv_ = c_ >> 3, ch_ = c_ & 7; \
            vreg[i_] = *(const v4u*)((const char*)(VT + (size_t)(hd * 128) * ldv + trow_) + (unsigned)(dv_ * ldv + 8 * ch_) * 2u); } } while (0)
#define AT_STORE(bufo) do { \
        _Pragma("unroll") for (int i_ = 0; i_ < 3; ++i_) { const int c_ = tid + 512 * i_, key_ = c_ / 24, ch_ = c_ - 24 * key_; *(LAS v4u*)(lds + (bufo) + key_ * AT_KROW + 16 * ch_) = kreg[i_]; } \
        _Pragma("unroll") for (int i_ = 0; i_ < 2; ++i_) { const int c_ = tid + 512 * i_, dv_ = c_ >> 3, ch_ = c_ & 7; \
            *(LAS v2u*)(lds + (bufo) + AT_VS + dv_ * AT_VROW + 16 * ch_) = (v2u){vreg[i_].x, vreg[i_].y}; *(LAS v2u*)(lds + (bufo) + AT_VS + dv_ * AT_VROW + 16 * ch_ + 8) = (v2u){vreg[i_].z, vreg[i_].w}; } } while (0)
    AT_LOAD(0);
    bf16x8 qf[12];
#pragma unroll
    for (int s = 0; s < 12; ++s) qf[s] = (bf16x8){0, 0, 0, 0, 0, 0, 0, 0};
    if (wact) {
        const bf16* qp = QA + (size_t)(qrow0 + 32 * w + r) * 1536 + hd * 192 + 8 * hh;
#pragma unroll
        for (int s = 0; s < 8; ++s) qf[s] = *(const bf16x8*)(qp + 16 * s);
        const int pos = pos0 + 32 * w + r;
        const float* ca = (const float*)(C.ws + WS_ROPEA); const float* sa = ca + 4096 * 32;
#pragma unroll
        for (int sp = 0; sp < 2; ++sp) {
            const bf16x8 x1 = *(const bf16x8*)(qp + 128 + 16 * sp), x2 = *(const bf16x8*)(qp + 160 + 16 * sp);
            const float* ct = ca + pos * 32 + 16 * sp + 8 * hh; const float* st = sa + pos * 32 + 16 * sp + 8 * hh;
            float o1[8], o2[8];
#pragma unroll
            for (int j = 0; j < 8; ++j) { const float a = bf2f((unsigned short)x1[j]), b = bf2f((unsigned short)x2[j]), c = ct[j], s = st[j]; o1[j] = a * c - b * s; o2[j] = a * s + b * c; }
            qf[8 + sp] = pack8(o1[0], o1[1], o1[2], o1[3], o1[4], o1[5], o1[6], o1[7]);
            qf[10 + sp] = pack8(o2[0], o2[1], o2[2], o2[3], o2[4], o2[5], o2[6], o2[7]);
        }
    }
    f32x16 ot[4];
#pragma unroll
    for (int db = 0; db < 4; ++db)
#pragma unroll
        for (int i = 0; i < 16; ++i) ot[db][i] = 0.f;
    float mrun = -1e30f, lrun = 0.f;
    const float CS = 0.07216878364870322f * 1.4426950408889634f;
    AT_STORE(0);
    __syncthreads();
    if (ntiles > 1) AT_LOAD(1);
    for (int j = 0; j < ntiles; ++j) {
        const int bo = (j & 1) * AT_BUF;
        if (wact && j <= jlim) {
            f32x16 s0, s1;
#pragma unroll
            for (int i = 0; i < 16; ++i) { s0[i] = 0.f; s1[i] = 0.f; }
#pragma unroll
            for (int s = 0; s < 12; ++s) {
                const bf16x8 a0 = *(const LAS bf16x8*)(lds + bo + r * AT_KROW + (16 * s + 8 * hh) * 2);
                const bf16x8 a1 = *(const LAS bf16x8*)(lds + bo + (32 + r) * AT_KROW + (16 * s + 8 * hh) * 2);
                s0 = MFMA32(a0, qf[s], s0); s1 = MFMA32(a1, qf[s], s1);
            }
            float mx = s0[0];
#pragma unroll
            for (int i = 0; i < 16; ++i) { mx = fmaxf(mx, s0[i]); mx = fmaxf(mx, s1[i]); }
            mx = fmaxf(mx, __shfl_xor(mx, 32));
            const float mnew = fmaxf(mrun, mx * CS);
            const float alpha = __builtin_amdgcn_exp2f(mrun - mnew);
            mrun = mnew; lrun *= alpha;
            if (__builtin_amdgcn_ballot_w64(alpha != 1.0f) != 0ull) {
#pragma unroll
                for (int db = 0; db < 4; ++db) ot[db] = ot[db] * alpha;
            }
#pragma unroll
            for (int i = 0; i < 16; ++i) { s0[i] = __builtin_amdgcn_exp2f(s0[i] * CS - mnew); s1[i] = __builtin_amdgcn_exp2f(s1[i] * CS - mnew); lrun += s0[i] + s1[i]; }
#pragma unroll
            for (int sub = 0; sub < 2; ++sub)
#pragma unroll
                for (int sp = 0; sp < 2; ++sp) {
                    const bf16x8 pf = sub == 0 ? pack8(s0[8 * sp], s0[8 * sp + 1], s0[8 * sp + 2], s0[8 * sp + 3], s0[8 * sp + 4], s0[8 * sp + 5], s0[8 * sp + 6], s0[8 * sp + 7])
                                               : pack8(s1[8 * sp], s1[8 * sp + 1], s1[8 * sp + 2], s1[8 * sp + 3], s1[8 * sp + 4], s1[8 * sp + 5], s1[8 * sp + 6], s1[8 * sp + 7]);
#pragma unroll
                    for (int db = 0; db < 4; ++db) {
                        const s16x4 lo = *(const LAS s16x4*)(lds + bo + AT_VS + (32 * db + r) * AT_VROW + (32 * sub + 16 * sp + 4 * hh) * 2);
                        const s16x4 hi = *(const LAS s16x4*)(lds + bo + AT_VS + (32 * db + r) * AT_VROW + (32 * sub + 16 * sp + 8 + 4 * hh) * 2);
                        ot[db] = MFMA32(cat4(lo, hi), pf, ot[db]);
                    }
                }
        }
        if (j + 1 < ntiles) { AT_STORE(AT_BUF - bo); }
        __syncthreads();
        if (j + 2 < ntiles) AT_LOAD(j + 2);
    }
    if (wact) {
        const float l = lrun + __shfl_xor(lrun, 32); const float inv = 1.0f / l;
        bf16* yp = Y + (size_t)(grp_row0(g) + qrow0 + 32 * w + r) * YW + 1024 + hd * 128 + 4 * hh;
#pragma unroll
        for (int db = 0; db < 4; ++db)
#pragma unroll
            for (int q = 0; q < 4; ++q) { v2u o; o.x = pk2(ot[db][4 * q] * inv, ot[db][4 * q + 1] * inv); o.y = pk2(ot[db][4 * q + 2] * inv, ot[db][4 * q + 3] * inv); *(v2u*)(yp + 32 * db + 8 * q) = o; }
    }
    __syncthreads();
#undef AT_TROW
#undef AT_LOAD
#undef AT_STORE
}

constexpr int SC_QROW = 272, SC_VROW = 576, SC_KCROW = 320, SC_HROW = 528;
constexpr int SC_QS = 0, SC_KS = 17408, SC_VS = 34816, SC_KSC = SC_VS + 64 * SC_VROW, SC_HT = SC_KSC + 64 * SC_KCROW, SC_SM = SC_HT + 64 * SC_HROW;
constexpr int SM_A = SC_SM, SM_MX = SM_A + 256, SM_PS = SM_MX + 256, SM_EM = SM_PS + 256, SM_WS = SM_EM + 256, SM_NQ = SM_WS + 256, SM_NV = SM_NQ + 256, SM_SC = SM_NV + 512, SM_RDW = SM_SC + 64;
static_assert(SM_RDW + 2048 <= 131072 && SC_SM % 16 == 0, "scan LDS");
#ifndef PROBE_SKIP
#define PROBE_SKIP 0
#endif
template <bool RET, bool sample, bool DRY = false>
__device__ __forceinline__ void scan_unit(Ctx& C, int layer, int bsel, int hd, const unsigned* ready = nullptr, unsigned need = 0u) {
    constexpr int SKIP = DRY ? PROBE_SKIP : 0;
    int w = C.wave; int lane = C.lane, tid = C.tid, r = lane & 31, hh = lane >> 5;
    int q4 = (lane & 15) >> 2, p4 = lane & 3, blk = (lane >> 4) & 1;
#define SC_LAUNDER() do { asm volatile("" : "+v"(lane)); asm volatile("" : "+s"(w)); tid = w * 64 + lane; r = lane & 31; hh = lane >> 5; q4 = (lane & 15) >> 2; p4 = lane & 3; blk = (lane >> 4) & 1; } while (0)
    SC_LAUNDER(); asm volatile("" : "+s"(C.ws), "+s"(C.out));
    LAS unsigned char* lds = C.lds;
    LAS float* A_ = (LAS float*)(lds + SM_A); LAS float* MX_ = (LAS float*)(lds + SM_MX); LAS float* PS_ = (LAS float*)(lds + SM_PS); LAS float* EM_ = (LAS float*)(lds + SM_EM);
    LAS float* WS_ = (LAS float*)(lds + SM_WS); LAS float* NQ_ = (LAS float*)(lds + SM_NQ); LAS float* NV_ = (LAS float*)(lds + SM_NV); LAS float* SC_ = (LAS float*)(lds + SM_SC);
    LAS float* RDW_ = (LAS float*)(lds + SM_RDW) + 64 * w;
    const bf16* Z = GPTR(GO_ZS); bf16* Y = GPTR(GO_Y);
    const int v0 = 32 * w;
    const int bglob = bsel;
    const int nch = sample ? 1 : 64;
    const size_t sidx = (size_t)(layer * 8 + bglob) * 4 + hd;
    const float KSCALE = 0.08838834764831845f;
    f32x16 Cacc[4];
#pragma unroll
    for (int db = 0; db < 4; ++db)
#pragma unroll
        for (int i = 0; i < 16; ++i) Cacc[db][i] = 0.f;
    if (sample) {
        if (!RET) {
            const float* c0 = cin(C, 4) + sidx * 256 * 128 + (size_t)(v0 + r) * 128;
#pragma unroll
            for (int db = 0; db < 4; ++db)
#pragma unroll
                for (int q = 0; q < 4; ++q) { const f32x4 t = *(const f32x4*)(c0 + 32 * db + 8 * q + 4 * hh); Cacc[db][4 * q] = t.x; Cacc[db][4 * q + 1] = t.y; Cacc[db][4 * q + 2] = t.z; Cacc[db][4 * q + 3] = t.w; }
        } else {
            const float* r0p = cin(C, 7) + sidx * 128 * 256 + v0 + r;
#pragma unroll
            for (int db = 0; db < 4; ++db)
#pragma unroll
                for (int i = 0; i < 16; ++i) Cacc[db][i] = r0p[(size_t)(32 * db + crow(i, hh)) * 256];
        }
    }
    if (!RET) {
        if (tid < 128) NV_[tid] = sample ? cin(C, 5)[sidx * 128 + tid] : 0.f;
        if (tid == 0) SC_[0] = sample ? cin(C, 6)[sidx] : 0.f;
    } else if (w == 0) {
        const float lg = log1pf(-exp2f(-5.0f - (float)hd));
        A_[lane] = -(float)lane * lg * 1.4426950408889634f; MX_[lane] = -(float)lane * lg * 1.4426950408889634f; PS_[lane] = expf((float)(lane + 1) * lg); WS_[lane] = expf((float)(63 - lane) * lg);
        if (lane == 0) SC_[1] = expf(64.0f * lg);
    }
    const float* cr = (const float*)(C.ws + WS_ROPER); const float* sr = cr + 4096 * 64;
    v4u pq[2], pk[2], pv[4]; float pig = 0.f, pfg = 0.f;
#define SC_ZROW(cn) (sample ? MP + bsel * 64 : bsel * 4096 + 64 * (cn))
#define SC_LOAD(cn) do { const char* Zn_ = (const char*)(Z + (size_t)SC_ZROW(cn) * ZSW); \
        if (!RET) { \
            _Pragma("unroll") for (int i_ = 0; i_ < 2; ++i_) { const int cc_ = tid + 512 * i_, row_ = cc_ >> 4, ch_ = cc_ & 15; const unsigned zo_ = (unsigned)(row_ * ZSW + hd * 128 + 8 * ch_) * 2u; \
                pq[i_] = *(const v4u*)(Zn_ + zo_ + ZS_MQ * 2); pk[i_] = *(const v4u*)(Zn_ + zo_ + ZS_MK * 2); } \
            if (w == 0) { const bf16* zr_ = (const bf16*)(Zn_ + (unsigned)(lane * ZSW + ZS_MISC + hd) * 2u); pig = bf2f(zr_[0]); pfg = bf2f(zr_[4]); } \
        } else { \
            const int row_ = tid >> 3, ch_ = tid & 7; const unsigned zo_ = (unsigned)(row_ * ZSW + hd * 128 + 8 * ch_) * 2u; \
            pq[0] = *(const v4u*)(Zn_ + zo_ + ZS_RQ * 2); pq[1] = *(const v4u*)(Zn_ + zo_ + ZS_RQ * 2 + 128); pk[0] = *(const v4u*)(Zn_ + zo_ + ZS_RK * 2); pk[1] = *(const v4u*)(Zn_ + zo_ + ZS_RK * 2 + 128); \
        } \
        _Pragma("unroll") for (int i_ = 0; i_ < 4; ++i_) { const int cc_ = tid + 512 * i_, row_ = cc_ >> 5, ch_ = cc_ & 31; \
            pv[i_] = *(const v4u*)(Zn_ + (unsigned)(row_ * ZSW + (RET ? ZS_RV : ZS_MV) + hd * 256 + 8 * ch_) * 2u); } } while (0)
#define SC_POLL(cn) do { if (ready && w == 0) { const unsigned* rp_ = ready + 16 * (SC_ZROW(cn) >> 8); unsigned sp_ = 0u; \
            while (__hip_atomic_load(rp_, __ATOMIC_RELAXED, __HIP_MEMORY_SCOPE_AGENT) < need) { __builtin_amdgcn_s_sleep(2); if (++sp_ > (1u << 17)) break; } \
            __builtin_amdgcn_fence(__ATOMIC_ACQUIRE, "agent"); asm volatile("s_waitcnt vmcnt(0)" ::: "memory"); } } while (0)
    SC_POLL(0);
    __syncthreads();
    SC_LOAD(0);
    for (int c = 0; c < nch; ++c) {
        const int zrow0 = SC_ZROW(c);
        SC_LAUNDER();
        const char* Zc = (const char*)(Z + (size_t)zrow0 * ZSW); char* Yc = (char*)(Y + (size_t)zrow0 * YW);
        if (!RET) {
#pragma unroll
            for (int i = 0; i < 2; ++i) { const int cc = tid + 512 * i, row = cc >> 4, ch = cc & 15;
                *(LAS v4u*)(lds + SC_QS + row * SC_QROW + 16 * ch) = pq[i]; *(LAS v4u*)(lds + SC_KS + row * SC_QROW + 16 * ch) = pk[i]; }
        } else {
            const int row = tid >> 3, ch = tid & 7;
            const unsigned to = (unsigned)(((sample ? PAST : 64 * c) + row) * 64 + 8 * ch) * 4u;
            f32x4 pcs[2], psn[2];
            pcs[0] = *(const f32x4*)((const char*)cr + to); pcs[1] = *(const f32x4*)((const char*)cr + to + 16); psn[0] = *(const f32x4*)((const char*)sr + to); psn[1] = *(const f32x4*)((const char*)sr + to + 16);
            const float cs[8] = {pcs[0].x, pcs[0].y, pcs[0].z, pcs[0].w, pcs[1].x, pcs[1].y, pcs[1].z, pcs[1].w}, sn[8] = {psn[0].x, psn[0].y, psn[0].z, psn[0].w, psn[1].x, psn[1].y, psn[1].z, psn[1].w};
#pragma unroll
            for (int which = 0; which < 2; ++which) {
                const v4u a = which ? pk[0] : pq[0], b = which ? pk[1] : pq[1];
                const float x1[8] = {blo(a.x), bhi(a.x), blo(a.y), bhi(a.y), blo(a.z), bhi(a.z), blo(a.w), bhi(a.w)}, x2[8] = {blo(b.x), bhi(b.x), blo(b.y), bhi(b.y), blo(b.z), bhi(b.z), blo(b.w), bhi(b.w)};
                const float sc = which ? KSCALE : 1.0f; float o1[8], o2[8];
#pragma unroll
                for (int j = 0; j < 8; ++j) { o1[j] = (x1[j] * cs[j] - x2[j] * sn[j]) * sc; o2[j] = (x1[j] * sn[j] + x2[j] * cs[j]) * sc; }
                v4u w1, w2; w1.x = pk2(o1[0], o1[1]); w1.y = pk2(o1[2], o1[3]); w1.z = pk2(o1[4], o1[5]); w1.w = pk2(o1[6], o1[7]); w2.x = pk2(o2[0], o2[1]); w2.y = pk2(o2[2], o2[3]); w2.z = pk2(o2[4], o2[5]); w2.w = pk2(o2[6], o2[7]);
                const int base = which ? SC_KS : SC_QS;
                *(LAS v4u*)(lds + base + row * SC_QROW + 16 * ch) = w1; *(LAS v4u*)(lds + base + row * SC_QROW + 16 * (ch + 8)) = w2;
            }
        }
#pragma unroll
        for (int i = 0; i < 4; ++i) { const int cc = tid + 512 * i, row = cc >> 5, ch = cc & 31; *(LAS v4u*)(lds + SC_VS + row * SC_VROW + 16 * ch) = pv[i]; }
        const float ig_c = pig, f_c = pfg;
        __syncthreads();
        if (!RET && !(SKIP & 1)) {
            if (w == 0) {
                const float ig = ig_c, f = f_c;
                const float lf = fminf(f, 0.f) - log1pf(expf(-fabsf(f)));
                float b = lf;
                b += dppk<0x111>(0.f, b); b += dppk<0x112>(0.f, b); b += dppk<0x114>(0.f, b); b += dppk<0x118>(0.f, b);
                { const float r1 = rdlane(b, 15), r2 = rdlane(b, 31), r3 = rdlane(b, 47); const int row = lane >> 4;
                  b += (row >= 1 ? r1 : 0.f) + (row >= 2 ? r2 : 0.f) + (row >= 3 ? r3 : 0.f); }
                const float a = ig - b; float am = a;
                am = fmaxf(am, dppk<0x111>(-3.0e38f, am)); am = fmaxf(am, dppk<0x112>(-3.0e38f, am)); am = fmaxf(am, dppk<0x114>(-3.0e38f, am)); am = fmaxf(am, dppk<0x118>(-3.0e38f, am));
                { const float r1 = rdlane(am, 15), r2 = rdlane(am, 31), r3 = rdlane(am, 47); const int row = lane >> 4;
                  am = fmaxf(am, fmaxf(row >= 1 ? r1 : -3.0e38f, fmaxf(row >= 2 ? r2 : -3.0e38f, row >= 3 ? r3 : -3.0e38f))); }
                const float mst = SC_[0];
                const float Mx = fmaxf(mst, am);
                A_[lane] = a * 1.4426950408889634f; MX_[lane] = Mx * 1.4426950408889634f + 3.5f; PS_[lane] = expf(mst - Mx); EM_[lane] = expf(-b - Mx);
                const float M63 = rdlane(Mx, 63), b63 = rdlane(b, 63);
                WS_[lane] = expf(a - M63);
                if (lane == 0) { SC_[1] = expf(mst - M63); SC_[0] = b63 + M63; }
            } else if (w == 1) {
                float acc = 0.f;
#pragma unroll
                for (int ch = 0; ch < 16; ++ch) { const v4u qv = *(const LAS v4u*)(lds + SC_QS + lane * SC_QROW + 16 * ch); const LAS float* nv = NV_ + 8 * ch;
                    acc += blo(qv.x) * nv[0] + bhi(qv.x) * nv[1] + blo(qv.y) * nv[2] + bhi(qv.y) * nv[3] + blo(qv.z) * nv[4] + bhi(qv.z) * nv[5] + blo(qv.w) * nv[6] + bhi(qv.w) * nv[7]; }
                NQ_[lane] = acc;
            }
        }
        __syncthreads();
        SC_LAUNDER();
        if (!(SKIP & 32))
#pragma unroll 1
        for (int i = 0; i < 2; ++i) { const int cc = tid + 512 * i, row = cc >> 4, ch = cc & 15; const v4u kv = *(const LAS v4u*)(lds + SC_KS + row * SC_QROW + 16 * ch);
            const float f = WS_[row] * (RET ? 1.0f : KSCALE);
            v4u o; o.x = pk2(blo(kv.x) * f, bhi(kv.x) * f); o.y = pk2(blo(kv.y) * f, bhi(kv.y) * f); o.z = pk2(blo(kv.z) * f, bhi(kv.z) * f); o.w = pk2(blo(kv.w) * f, bhi(kv.w) * f);
            *(LAS v4u*)(lds + SC_KSC + row * SC_KCROW + 16 * ch) = o; }
        f32x16 Zl[2];
#pragma unroll
        for (int lb = 0; lb < 2; ++lb)
#pragma unroll
            for (int i = 0; i < 16; ++i) Zl[lb][i] = 0.f;
        __builtin_amdgcn_sched_barrier(0);
        if (!(SKIP & 2))
#pragma unroll
        for (int db = 0; db < 4; ++db) {
            const bf16x8 cfa = pack8(Cacc[db][0], Cacc[db][1], Cacc[db][2], Cacc[db][3], Cacc[db][4], Cacc[db][5], Cacc[db][6], Cacc[db][7]);
            const bf16x8 cfb = pack8(Cacc[db][8], Cacc[db][9], Cacc[db][10], Cacc[db][11], Cacc[db][12], Cacc[db][13], Cacc[db][14], Cacc[db][15]);
#pragma unroll
            for (int lb = 0; lb < 2; ++lb) {
                const LAS unsigned char* qb_ = lds + SC_QS + (32 * lb + r) * SC_QROW + (32 * db + 4 * hh) * 2;
                const s16x4 lo0 = *(const LAS s16x4*)(qb_), hi0 = *(const LAS s16x4*)(qb_ + 16), lo1 = *(const LAS s16x4*)(qb_ + 32), hi1 = *(const LAS s16x4*)(qb_ + 48);
                Zl[lb] = MFMA32(cat4(lo0, hi0), cfa, Zl[lb]);
                Zl[lb] = MFMA32(cat4(lo1, hi1), cfb, Zl[lb]);
            }
        }
#pragma unroll
        for (int lb = 0; lb < 2; ++lb)
#pragma unroll
            for (int q = 0; q < 4; ++q) { const f32x4 pv4 = *(const LAS f32x4*)(PS_ + 32 * lb + 8 * q + 4 * hh); Zl[lb][4 * q] *= pv4.x; Zl[lb][4 * q + 1] *= pv4.y; Zl[lb][4 * q + 2] *= pv4.z; Zl[lb][4 * q + 3] *= pv4.w; }
        __builtin_amdgcn_sched_barrier(0);
        SC_LAUNDER();
        v2u zgr[8];
#pragma unroll
        for (int i = 0; i < 8; ++i) zgr[i] = *(const v2u*)(Zc + (unsigned)((8 * w + i) * ZSW + (RET ? ZS_RG : ZS_MO) + hd * 256 + 4 * lane) * 2u);
        float den[2] = {0.f, 0.f};
        if (!(SKIP & 4))
#pragma unroll
        for (int blkid = 0; blkid < 3; ++blkid) {
            const int sb = blkid == 2 ? 1 : 0, lb = blkid == 0 ? 0 : 1;
            f32x16 wt;
#pragma unroll
            for (int i = 0; i < 16; ++i) wt[i] = 0.f;
#pragma unroll
            for (int s = 0; s < 8; ++s) {
                const bf16x8 ka = *(const LAS bf16x8*)(lds + SC_KS + (32 * sb + r) * SC_QROW + (16 * s + 8 * hh) * 2);
                const bf16x8 qb = *(const LAS bf16x8*)(lds + SC_QS + (32 * lb + r) * SC_QROW + (16 * s + 8 * hh) * 2);
                wt = MFMA32(ka, qb, wt);
            }
            const int l = 32 * lb + r; const float Ml = MX_[l];
#pragma unroll
            for (int q = 0; q < 4; ++q) { const f32x4 av4 = *(const LAS f32x4*)(A_ + 32 * sb + 8 * q + 4 * hh); const float av[4] = {av4.x, av4.y, av4.z, av4.w};
#pragma unroll
                for (int k = 0; k < 4; ++k) { const int i = 4 * q + k; const int si = 32 * sb + crow(i, hh); const float e = __builtin_amdgcn_exp2f(av[k] - Ml); const float fct = (sb != lb || si <= l) ? e : 0.f; wt[i] *= fct; den[lb] += wt[i]; } }
#pragma unroll
            for (int sp = 0; sp < 2; ++sp) {
                const bf16x8 wf = pack8(wt[8 * sp], wt[8 * sp + 1], wt[8 * sp + 2], wt[8 * sp + 3], wt[8 * sp + 4], wt[8 * sp + 5], wt[8 * sp + 6], wt[8 * sp + 7]);
                const s16x4 lo = trrd(lds + SC_VS + (32 * sb + 16 * sp + 4 * hh + q4) * SC_VROW + (v0 + 16 * blk + 4 * p4) * 2);
                const s16x4 hi = trrd(lds + SC_VS + (32 * sb + 16 * sp + 8 + 4 * hh + q4) * SC_VROW + (v0 + 16 * blk + 4 * p4) * 2);
                Zl[lb] = MFMA32(wf, cat4(lo, hi), Zl[lb]);
            }
            __builtin_amdgcn_sched_barrier(0);
        }
        if (!RET) {
#pragma unroll
            for (int lb = 0; lb < 2; ++lb) { const int l = 32 * lb + r; const float d = den[lb] + __shfl_xor(den[lb], 32) + PS_[l] * NQ_[l];
                const float rd = 1.0f / fmaxf(fabsf(d), EM_[l]); if (hh == 0) RDW_[l] = rd; }
#pragma unroll
            for (int lb = 0; lb < 2; ++lb)
#pragma unroll
                for (int q = 0; q < 4; ++q) { const f32x4 rv4 = *(const LAS f32x4*)(RDW_ + 32 * lb + 8 * q + 4 * hh); Zl[lb][4 * q] *= rv4.x; Zl[lb][4 * q + 1] *= rv4.y; Zl[lb][4 * q + 2] *= rv4.z; Zl[lb][4 * q + 3] *= rv4.w; }
        }
#pragma unroll
        for (int lb = 0; lb < 2; ++lb)
#pragma unroll
            for (int i = 0; i < 16; ++i) *(LAS unsigned short*)(lds + SC_HT + (32 * lb + crow(i, hh)) * SC_HROW + (v0 + r) * 2) = (unsigned short)f2bf(Zl[lb][i]);
        if (c + 1 < nch && ((c + 1) & 3) == 0) SC_POLL(c + 1);
        __syncthreads();
        SC_LAUNDER();
        if (c + 1 < nch) SC_LOAD(c + 1);
        if (!(SKIP & 8))
        {
            const float carry = SC_[1];
#pragma unroll
            for (int db = 0; db < 4; ++db) Cacc[db] = Cacc[db] * carry;
            f32x16 nacc;
#pragma unroll
            for (int i = 0; i < 16; ++i) nacc[i] = 0.f;
            const bf16x8 ones = (bf16x8){0x3F80, 0x3F80, 0x3F80, 0x3F80, 0x3F80, 0x3F80, 0x3F80, 0x3F80};
#pragma unroll
            for (int sp = 0; sp < 4; ++sp) {
                const s16x4 vlo = trrd(lds + SC_VS + (16 * sp + 8 * hh + q4) * SC_VROW + (v0 + 16 * blk + 4 * p4) * 2);
                const s16x4 vhi = trrd(lds + SC_VS + (16 * sp + 8 * hh + 4 + q4) * SC_VROW + (v0 + 16 * blk + 4 * p4) * 2);
                const bf16x8 vb = cat4(vlo, vhi);
#pragma unroll
                for (int db = 0; db < 4; ++db) {
                    const s16x4 klo = trrd(lds + SC_KSC + (16 * sp + 8 * hh + q4) * SC_KCROW + (32 * db + 16 * blk + 4 * p4) * 2);
                    const s16x4 khi = trrd(lds + SC_KSC + (16 * sp + 8 * hh + 4 + q4) * SC_KCROW + (32 * db + 16 * blk + 4 * p4) * 2);
                    const bf16x8 ka = cat4(klo, khi);
                    Cacc[db] = MFMA32(ka, vb, Cacc[db]);
                    if (!RET && db == w) nacc = MFMA32(ka, ones, nacc);
                }
            }
            if (!RET && w < 4 && r == 0) {
#pragma unroll
                for (int i = 0; i < 16; ++i) { const int d = 32 * w + crow(i, hh); NV_[d] = carry * NV_[d] + nacc[i]; }
            }
        }
        __builtin_amdgcn_sched_barrier(0);
        SC_LAUNDER();
        if (!(SKIP & 16))
        {
            const float* gain = (RET ? cin(C, 18) : cin(C, 11)) + layer * 1024 + hd * 256 + 4 * lane;
            const f32x4 gg = *(const f32x4*)gain;
#pragma unroll
            for (int i = 0; i < 8; ++i) {
                const int l = 8 * w + i;
                const v2u hv = *(const LAS v2u*)(lds + SC_HT + l * SC_HROW + 8 * lane);
                float x0 = blo(hv.x), x1 = bhi(hv.x), x2 = blo(hv.y), x3 = bhi(hv.y);
                if (RET) { const float mean = wave_sum((x0 + x1) + (x2 + x3)) * (1.f / 256.f); x0 -= mean; x1 -= mean; x2 -= mean; x3 -= mean; }
                const float rs = rsqrtf(wave_sum((x0 * x0 + x1 * x1) + (x2 * x2 + x3 * x3)) * (1.f / 256.f) + EPS);
                const v2u zg = zgr[i];
                v2u o; o.x = pk2(x0 * rs * gg.x * blo(zg.x), x1 * rs * gg.y * bhi(zg.x)); o.y = pk2(x2 * rs * gg.z * blo(zg.y), x3 * rs * gg.w * bhi(zg.y));
                if (!DRY) *(v2u*)(Yc + (unsigned)(l * YW + (RET ? 2048 : 0) + hd * 256 + 4 * lane) * 2u) = o; else asm volatile("" :: "v"(o.x), "v"(o.y));
            }
        }
        __syncthreads();
    }
    SC_LAUNDER();
    if (!DRY)
    {
        float* ob = C.out;
        if (!RET) {
            float* co = ob + (sample ? O_SC : O_PC) + sidx * 256 * 128 + (size_t)(v0 + r) * 128;
#pragma unroll
            for (int db = 0; db < 4; ++db)
#pragma unroll
                for (int q = 0; q < 4; ++q) { const f32x4 t = {Cacc[db][4 * q], Cacc[db][4 * q + 1], Cacc[db][4 * q + 2], Cacc[db][4 * q + 3]}; *(f32x4*)(co + 32 * db + 8 * q + 4 * hh) = t; }
            if (tid < 128) ob[(sample ? O_SN : O_PN) + sidx * 128 + tid] = NV_[tid];
            if (tid == 0) ob[(sample ? O_SM : O_PM) + sidx] = SC_[0];
        } else {
            float* ro = ob + (sample ? O_SR : O_PR) + sidx * 128 * 256 + v0 + r;
#pragma unroll
            for (int db = 0; db < 4; ++db)
#pragma unroll
                for (int i = 0; i < 16; ++i) ro[(size_t)(32 * db + crow(i, hh)) * 256] = Cacc[db][i];
        }
    }
    __syncthreads();
#undef SC_LOAD
#undef SC_POLL
#undef SC_ZROW
#undef SC_LAUNDER
}

__device__ __forceinline__ void scan_phase(Ctx& C, int layer, int rep, const unsigned* ready) {
    volatile LAS unsigned* WQ = (volatile LAS unsigned*)(C.lds + MISC_OFF);
    unsigned* ctr = (unsigned*)(C.ws + WS_CTL) + 8 + layer + 16 * rep;
    for (;;) {
        { int t_ = C.lane; asm volatile("" : "+v"(t_)); if (C.wave == 0 && t_ == 0) WQ[0] = __hip_atomic_fetch_add(ctr, 1u, __ATOMIC_RELAXED, __HIP_MEMORY_SCOPE_AGENT); }
        __syncthreads();
        int it = (int)WQ[0];
        __syncthreads();
        if (it >= 64) break;
        if (it < 32) { scan_unit<false, true>(C, layer, it >> 2, it & 3, ready, 8u * (ZSW / 256)); continue; } it -= 32;
        scan_unit<true, true>(C, layer, it >> 2, it & 3, ready, 8u * (ZSW / 256));
    }
    if (layer == 0 && rep == 0) {
        unsigned* ctr2 = (unsigned*)(C.ws + WS_CTL) + 12;
        LAS float* scr = (LAS float*)(C.lds + C.wave * 16384);
        for (;;) {
            { int t_ = C.lane; asm volatile("" : "+v"(t_)); if (C.wave == 0 && t_ == 0) WQ[0] = __hip_atomic_fetch_add(ctr2, 1u, __ATOMIC_RELAXED, __HIP_MEMORY_SCOPE_AGENT); }
            __syncthreads();
            const int ch = (int)WQ[0];
            __syncthreads();
            constexpr int W_L0REST = W_NITEMS - W_I_IN - W_I_UQ - 2 * W_I_UK;
            if (ch * 64 >= W_L0REST + W_NITEMS) break;
#pragma unroll 1
            for (int j = 0; j < 8; ++j) { const int it2 = ch * 64 + j * 8 + C.wave;
                if (it2 < W_L0REST) weight_item(C, 0, W_I_IN + it2, scr); else if (it2 < W_L0REST + W_NITEMS) weight_item(C, 1, it2 - W_L0REST, scr); }
        }
    }
}
__device__ __forceinline__ void attn_phase(Ctx& C, int layer, int g, int rep) {
    volatile LAS unsigned* WQ = (volatile LAS unsigned*)(C.lds + MISC_OFF);
    unsigned* ctr = (unsigned*)(C.ws + WS_CTL) + (layer * 3 + g) + 16 * rep;
    const int nbg = g < 2 ? 3 : 2;
    const int n_pa = nbg * 8 * 16;
    const int n_sa = g == 2 ? 64 : 0;
    for (;;) {
        { int t_ = C.lane; asm volatile("" : "+v"(t_)); if (C.wave == 0 && t_ == 0) WQ[0] = __hip_atomic_fetch_add(ctr, 1u, __ATOMIC_RELAXED, __HIP_MEMORY_SCOPE_AGENT); }
        __syncthreads();
        int it = (int)WQ[0];
        __syncthreads();
        if (it >= n_pa + n_sa) break;
        if (it < n_pa) { int qt, rem; if (g < 2) { qt = 15 - it / 24; rem = it % 24; } else { qt = 15 - (it >> 4); rem = it & 15; } attn_unit(C, g, false, rem >> 3, rem & 7, qt); continue; } it -= n_pa;
        attn_unit(C, g, true, it >> 3, it & 7, 0);
    }
}

typedef GAS unsigned gu32;
#define XB_TMO      128
#define XB_XCNT(j)  (256  + 64 * (j))
#define XB_XSUB(j)  (1280 + 64 * (j))
#define XB_XGEN(j)  (2304 + 64 * (j))
#define XB_TOP      3328
#define XB_TOPGEN   3392
#define XCD_BAR_WORDS 3456
#define XB_SPIN_CAP (1u << 18)

__device__ __forceinline__ unsigned xb_ld(unsigned* p)              { return __hip_atomic_load(p, __ATOMIC_RELAXED, __HIP_MEMORY_SCOPE_AGENT); }
__device__ __forceinline__ unsigned xb_add(unsigned* p, unsigned v) { return __hip_atomic_fetch_add(p, v, __ATOMIC_RELAXED, __HIP_MEMORY_SCOPE_AGENT); }
__device__ __forceinline__ unsigned xb_xcc_id() { return (unsigned)__builtin_amdgcn_s_getreg((3 << 11) | 20) & 0xFu; }
#define XB_SPIN(cond, bar) do { unsigned _sp = 0; while (cond) { __builtin_amdgcn_s_sleep(1); \
    if ((++_sp & 255u) == 0u) { if (xb_ld(&(bar)[XB_TMO])) break; if (_sp > XB_SPIN_CAP) { atomicAdd(&(bar)[XB_TMO], 1u); break; } } } } while (0)

struct XcdBarrier {
    unsigned* bar; unsigned x;
    volatile LAS unsigned* st;
};

__device__ __forceinline__ XcdBarrier xcd_barrier_post(unsigned* bar, volatile LAS unsigned* st) {
    XcdBarrier b; b.bar = bar; b.x = xb_xcc_id(); b.st = st;
    if (threadIdx.x == 0) (void)xb_add(&bar[XB_XCNT(b.x)], 1u);
    return b;
}
__device__ __forceinline__ void xcd_barrier_complete(unsigned* bar, unsigned x, unsigned& nloc, unsigned& nx) {
    const unsigned G = gridDim.x * gridDim.y * gridDim.z;
    unsigned sum, cnt, mine, sp = 0u;
    for (;;) {
        sum = 0u; cnt = 0u; mine = 0u;
#pragma unroll
        for (unsigned j = 0; j < 16; ++j) { const unsigned c = xb_ld(&bar[XB_XCNT(j)]); sum += c; cnt += (c > 0u) ? 1u : 0u; mine = (j == x) ? c : mine; }
        if (sum == G) break;
        __builtin_amdgcn_s_sleep(1);
        if ((++sp & 255u) == 0u) { if (xb_ld(&bar[XB_TMO])) break; if (sp > XB_SPIN_CAP) { atomicAdd(&bar[XB_TMO], 1u); break; } }
    }
    nloc = mine > 0u ? mine : 1u; nx = cnt > 0u ? cnt : 1u;
}

__device__ __forceinline__ void xcd_barrier(const XcdBarrier& b) {
    asm volatile("s_waitcnt vmcnt(0)" ::: "memory");
    __syncthreads();
    if (threadIdx.x == 0) {
        unsigned* bar = b.bar;
        __builtin_amdgcn_s_waitcnt(0);
        unsigned nloc = b.st[0], nx = b.st[1];
        if (nloc == 0u) { xcd_barrier_complete(bar, b.x, nloc, nx); b.st[0] = nloc; b.st[1] = nx; }
        const unsigned old = xb_add(&bar[XB_XSUB(b.x)], 1u);
        const unsigned gen = old / nloc;
        if (old + 1u == (gen + 1u) * nloc) {
            __builtin_amdgcn_fence(__ATOMIC_RELEASE, "agent");
            asm volatile("s_waitcnt vmcnt(0)" ::: "memory");
            const unsigned og = xb_add(&bar[XB_TOP], 1u);
            const unsigned tg = og / nx;
            if (og + 1u == (tg + 1u) * nx) xb_add(&bar[XB_TOPGEN], 1u);
            else XB_SPIN(xb_ld(&bar[XB_TOPGEN]) == tg, bar);
            __builtin_amdgcn_fence(__ATOMIC_ACQUIRE, "agent");
            xb_add(&bar[XB_XGEN(b.x)], 1u);
            asm volatile("s_waitcnt vmcnt(0)" ::: "memory");
        } else {
            XB_SPIN(xb_ld(&bar[XB_XGEN(b.x)]) == gen, bar);
            __builtin_amdgcn_fence(__ATOMIC_ACQUIRE, "agent");
            asm volatile("s_waitcnt vmcnt(0)" ::: "memory");
        }
    }
    __syncthreads();
}

constexpr int CW_BAR = 4096;
#ifndef EN_MASK
#define EN_MASK 1023
#endif
constexpr int EN = EN_MASK;
__global__ void __launch_bounds__(NTHR, 2) mega_fwd(Args args) {
    extern __shared__ __attribute__((aligned(16))) unsigned char lds_raw[];
    cg::grid_group grid = cg::this_grid();
    Ctx C;
    C.lds = (LAS unsigned char*)lds_raw; C.tid = threadIdx.x; C.lane = C.tid & 63; C.wave = __builtin_amdgcn_readfirstlane(C.tid >> 6); C.G = gridDim.x; C.bid = blockIdx.x;
    if (C.tid == 0) {
#pragma unroll
        for (int i = 0; i < 26; ++i) *(LAS unsigned long long*)(C.lds + MISC_OFF + 64 + 8 * i) = (unsigned long long)args.in[i];
    }
    C.out = args.out; C.ws = args.ws;
    if (C.tid == 0) { ((volatile LAS unsigned*)(C.lds + MISC_OFF))[4] = 0u; ((volatile LAS unsigned*)(C.lds + MISC_OFF))[5] = 0u; }
    __syncthreads();
    XcdBarrier bar = xcd_barrier_post((unsigned*)(C.ws + WS_CTL) + CW_BAR, (volatile LAS unsigned*)(C.lds + MISC_OFF) + 4);
#define PHASE_BEGIN { asm volatile("" : "+s"(C.ws), "+s"(C.out)); asm volatile("" : "+s"(C.bid), "+s"(C.G));
#define PHASE_END(dosync) if (dosync) xcd_barrier(bar); }
#define PHASE_END_CG(dosync) if (dosync) grid.sync(); }
    LAS unsigned char* ring = C.lds;
    bf16* XB = (bf16*)(C.ws + WS_XB);

    PHASE_BEGIN if (EN & 1) p0_prologue(C); PHASE_END_CG(true)

    for (int layer = 0; layer < 2; ++layer) {
        PHASE_BEGIN {
            unsigned* ready = (unsigned*)(C.ws + WS_CTL) + 8192 + layer * 2080;
            if (C.bid < 64) {
                const int it = C.bid;
                if (it < 32) scan_unit<false, false>(C, layer, it >> 2, it & 3, ready, 8u * (ZSW / 256));
                else scan_unit<true, false>(C, layer, (it - 32) >> 2, it & 3, ready, 8u * (ZSW / 256));
            } else {
                pg8::Gemm gm{XB, WPTR(layer, WO_IN), MT, ZSW, DM}; pg8::ChunkOrder S; S.init(ZSW / 256, C.G - 64, C.bid - 64, ready);
                pg8::EpiBf16 E{GPTR(GO_ZS), ZSW, (const float*)(C.ws + WS_W + (size_t)layer * W_LAYER + WO_BIAS), 1 | 256, -1, -1};
                pg8::gemm_phase<pg8::EpiBf16, pg8::ChunkOrder, true, true>(ring, gm, S, E);
            }
            scan_phase(C, layer, 0, ready);
        } PHASE_END(true)
        for (int g = 0; g < 3; ++g) {
            const int rows = grp_rows(g), r0 = grp_row0(g), ckr = grp_ck(g);
            PHASE_BEGIN if (EN & 2) {
                pg8::Gemm gm{XB + (size_t)r0 * DM, WPTR(layer, WO_IN) + (size_t)ZSW * DM, rows, ZRW, DM}; pg8::StaticOrder S; S.init(rows, ZRW, C.G, C.bid);
                pg8::EpiBf16 E{GPTR(GO_Z), ZRW, (const float*)(C.ws + WS_W + (size_t)layer * W_LAYER + WO_BIAS) + ZSW, 2, -1, -1};
                pg8::gemm_phase<pg8::EpiBf16, pg8::StaticOrder, true, true>(ring, gm, S, E);
            } PHASE_END(true)
            PHASE_BEGIN if (EN & 4) pe_phase(C, layer, g); PHASE_END(true)
            PHASE_BEGIN if (EN & 8) {
                pg8::Gemm gm{GPTR(GO_QN), WPTR(layer, WO_UQ), 0, 0, 512, 512, 1 << 20, 0, GPTR(GO_CK), WPTR(layer, WO_UK), WPTR(layer, WO_V), GPTR(GO_CK)};
                pg8::TriOrder S; S.init(rows / 256, 6, ckr / 256, 4, 4, ckr / 256, C.G, C.bid);
                pg8::EpiBf16 E{GPTR(GO_QA), 1536, nullptr, 0, -1, -1, GPTR(GO_KN), 1024, GPTR(GO_VT), ckr};
                pg8::gemm_phase<pg8::EpiBf16, pg8::TriOrder, true, true>(ring, gm, S, E);
            } PHASE_END(true)
            PHASE_BEGIN if (EN & 16) attn_phase(C, layer, g, 0); PHASE_END(true)
            PHASE_BEGIN if (EN & 32) {
                pg8::Gemm gm{GPTR(GO_Y) + (size_t)r0 * YW, WPTR(layer, WO_UP), rows, DM, YW}; pg8::StaticOrder S; S.init(rows, DM, C.G, C.bid);
                pg8::EpiUp E{XB + (size_t)r0 * DM, DM, GPTR(GO_Z), 16, 32};
                pg8::gemm_phase<pg8::EpiUp, pg8::StaticOrder, true, true>(ring, gm, S, E);
            } PHASE_END(true)
        }
        PHASE_BEGIN if (EN & 64) {
            { pg8::Gemm gm{XB, WPTR(layer, WO_O), MP, DM, DM}; pg8::StaticOrder S; S.init(MP, DM, C.G, C.bid);
              pg8::EpiBf16 E{GPTR(GO_MIX), DM, nullptr, 0, -1, -1}; pg8::gemm_phase<pg8::EpiBf16, pg8::StaticOrder, true, true>(ring, gm, S, E); }
            { pg8::Gemm gm{XB + (size_t)MP * DM, WPTR(layer, WO_O), MS * 4, DM, 512, DM, 2, 512}; pg8::StaticOrder S; S.init(MS * 4, DM, C.G, C.bid);
              pg8::EpiBf16 E{GPTR(GO_TP), DM, nullptr, 0, -1, -1}; pg8::gemm_phase<pg8::EpiBf16, pg8::StaticOrder, true, true>(ring, gm, S, E); }
        } PHASE_END(true)
        PHASE_BEGIN if (EN & 128) px_phase(C, GPTR(GO_MIX), GPTR(GO_TP), 4, cin(C, 21) + layer * DM, cin(C, 22) + layer * DM, layer == 0); PHASE_END(true)
        PHASE_BEGIN if (EN & 256) {
            pg8::Gemm gm{XB, WPTR(layer, WO_GU), MT, 2 * DFF, DM}; pg8::StaticOrder S; S.init(MT, 2 * DFF, C.G, C.bid);
            pg8::EpiSwi E{GPTR(GO_ACT), DFF, -1, -1};
            pg8::gemm_phase<pg8::EpiSwi, pg8::StaticOrder, true, true>(ring, gm, S, E);
        } PHASE_END(true)
        PHASE_BEGIN if (EN & 512) {
            { pg8::Gemm gm{GPTR(GO_ACT), WPTR(layer, WO_DOWN), MP, DM, DFF}; pg8::StaticOrder S; S.init(MP, DM, C.G, C.bid);
              pg8::EpiBf16 E{GPTR(GO_MIX), DM, nullptr, 0, -1, -1}; pg8::gemm_phase<pg8::EpiBf16, pg8::StaticOrder, true, true>(ring, gm, S, E); }
            { pg8::Gemm gm{GPTR(GO_ACT) + (size_t)MP * DFF, WPTR(layer, WO_DOWN), MS * 11, DM, 512, DFF, 2, 512}; pg8::StaticOrder S; S.init(MS * 11, DM, C.G, C.bid);
              pg8::EpiBf16 E{GPTR(GO_TP), DM, nullptr, 0, -1, -1}; pg8::gemm_phase<pg8::EpiBf16, pg8::StaticOrder, true, true>(ring, gm, S, E); }
        } PHASE_END(true)
        PHASE_BEGIN if (EN & 128) px_phase(C, GPTR(GO_MIX), GPTR(GO_TP), 11, cin(C, 25) + layer * DM, layer == 0 ? cin(C, 8) + DM : nullptr, false); PHASE_END(true)
    }
#undef PHASE_BEGIN
#undef PHASE_END
#undef PHASE_END_CG
}

extern "C" void kernel_launch(void* const* d_in, const int* in_sizes, int n_in, void* d_out, int out_size, void* d_ws, size_t ws_size, hipStream_t stream) {
    static int grid = 0;
    if (grid == 0) {
        if (n_in != 26 || in_sizes[0] != MP * DM || (size_t)out_size != O_END || ws_size < WS_END) {
            fprintf(stderr, "kernel_launch: shape mismatch n_in %d in0 %d out %d ws %zu (need %zu)\n", n_in, n_in > 0 ? in_sizes[0] : -1, out_size, ws_size, (size_t)WS_END); grid = -1; return; }
        int dev = 0, cus = 0, per_cu = 0;
        hipGetDevice(&dev); hipDeviceGetAttribute(&cus, hipDeviceAttributeMultiprocessorCount, dev);
        hipFuncSetAttribute((const void*)mega_fwd, hipFuncAttributeMaxDynamicSharedMemorySize, LDS_BYTES);
        hipOccupancyMaxActiveBlocksPerMultiprocessor(&per_cu, (const void*)mega_fwd, NTHR, LDS_BYTES);
        (void)hipGetLastError();
        if (per_cu < 1) per_cu = 1;
        grid = cus * 1;
        if (grid <= 0) grid = 256;
    }
    if (grid < 0) return;
    if (hipMemsetAsync((char*)d_ws + WS_CTL, 0, 65536, stream) != hipSuccess) { fprintf(stderr, "memset failed\n"); return; }
    Args a{};
    for (int i = 0; i < 26; ++i) a.in[i] = (const float*)d_in[i];
    a.out = (float*)d_out; a.ws = (unsigned char*)d_ws; a.ph_lo = 0; a.ph_hi = 1000;
    void* kargs[] = {&a};
    hipError_t e = hipLaunchCooperativeKernel((const void*)mega_fwd, dim3(grid), dim3(NTHR), kargs, LDS_BYTES, stream);
    if (e != hipSuccess) fprintf(stderr, "cooperative launch failed: %s (grid %d)\n", hipGetErrorString(e), grid);
}
```

```cpp
#include <hip/hip_runtime.h>
#include <hip/hip_cooperative_groups.h>
#include <cstdio>
#include <cstdint>
namespace cg = cooperative_groups;
namespace pg8 {
#define PG8_LAS __attribute__((address_space(3)))
typedef unsigned short bf16_t;
typedef short bf16x8 __attribute__((ext_vector_type(8)));
typedef float f32x4 __attribute__((ext_vector_type(4)));
typedef unsigned u32x4 __attribute__((ext_vector_type(4)));
constexpr int BM = 256, BK = 64, HALF = 128, HTB = HALF * BK * 2  , STAGE_BYTES = 8 * HTB, NXCD = 8, WGM = 8;

__host__ __device__ __forceinline__ int lds_byte(int r, int c) { const int st = (r >> 4) * 2 + (c >> 5), rr = r & 15, cc = c & 31, ob = rr * 64 + cc * 2; return st * 1024 + (ob ^ (((ob >> 9) & 1) << 5)); }
__host__ __device__ __forceinline__ void stage_rc(int b, int& R, int& C) { const int st = b / 1024, sb = b % 1024, swz = sb ^ (((sb >> 9) & 1) << 5); R = (st >> 1) * 16 + swz / 64; C = (st & 1) * 32 + (swz % 64) / 2; }
__host__ __device__ __forceinline__ int perm32(int rho) { const int n = rho >> 4, i = rho & 15; return 8 * (i >> 2) + 4 * n + (i & 3); }

struct Unit { int pm, pn; int seg = 0; };
struct Gemm { const bf16_t* A; const bf16_t* Bt; int M, N, K; int ld = 0, nMr = 1 << 20, kslice = 0; const bf16_t* A1 = nullptr; const bf16_t* Bt1 = nullptr; const bf16_t* A2 = nullptr; const bf16_t* Bt2 = nullptr; };

struct StaticOrder {
    int nM, nN, nwg, G, c;
    __host__ __device__ void init(int M, int N, int G_, int c_) { nM = M / BM; nN = N / BM; nwg = nM * nN; G = G_; c = c_; }
    __host__ __device__ bool next(int i, Unit& u) const {
        const long L = (long)i * G + c; if (L >= nwg) return false;
        int wgid = (int)L; { const int q = nwg / NXCD, r = nwg % NXCD, xcd = wgid % NXCD, off = wgid / NXCD; wgid = (xcd < r ? xcd * (q + 1) : r * (q + 1) + (xcd - r) * q) + off; }
        const int nig = WGM * nN, gid = wgid / nig, fm = gid * WGM, gsz = (nM - fm) < WGM ? (nM - fm) : WGM;
        u.pm = fm + ((wgid % nig) % gsz); u.pn = (wgid % nig) / gsz; return true;
    }
    __device__ __forceinline__ void a_ready(const Unit&) const {}
    __device__ __forceinline__ void done(const Unit&) const {}
};


struct TriOrder {
    int n0, n1, n2, nN0, nN1, nN2, G, c;
    __host__ __device__ void init(int nM0_, int nN0_, int nM1_, int nN1_, int nM2_, int nN2_, int G_, int c_) { nN0 = nN0_; nN1 = nN1_; nN2 = nN2_; n0 = nM0_ * nN0_; n1 = nM1_ * nN1_; n2 = nM2_ * nN2_; G = G_; c = c_; }
    __host__ __device__ bool next(int i, Unit& u) const {
        int L = i * G + c; if (L >= n0 + n1 + n2) return false;
        if (L < n0) { u.seg = 0; u.pm = L / nN0; u.pn = L % nN0; return true; } L -= n0;
        if (L < n1) { u.seg = 1; u.pm = L / nN1; u.pn = L % nN1; return true; } L -= n1;
        u.seg = 2; u.pm = L / nN2; u.pn = L % nN2; return true;
    }
    __device__ __forceinline__ void a_ready(const Unit&) const {}
    __device__ __forceinline__ void done(const Unit&) const {}
};

struct ChunkOrder {
    int nN, G, c; unsigned* ready;
    __host__ __device__ void init(int nN_, int G_, int c_, unsigned* ready_) { nN = nN_; G = G_; c = c_; ready = ready_; }
    __host__ __device__ bool next(int i, Unit& u) const {
        int L = i * G + c; const int per = 8 * nN, nmain = 16 * per;
        if (L >= nmain + 2 * nN) return false;
        if (L < nmain) { const int t = L / per, idx = L % per; u.pm = (idx & 7) * 16 + t; u.pn = idx >> 3; return true; }
        L -= nmain; u.pm = 128 + (L & 1); u.pn = L >> 1; return true;
    }
    __device__ __forceinline__ void a_ready(const Unit&) const {}
    __device__ __forceinline__ void done(const Unit& u) const {
        asm volatile("s_waitcnt vmcnt(0)" ::: "memory");
        if ((threadIdx.x & 63) == 0) __hip_atomic_fetch_add(ready + 16 * u.pm, 1u, __ATOMIC_RELAXED, __HIP_MEMORY_SCOPE_AGENT);
    }
};
__device__ __forceinline__ unsigned cvt_pk_bf16(float lo, float hi) { unsigned r; asm volatile("v_cvt_pk_bf16_f32 %0, %1, %2" : "=v"(r) : "v"(lo), "v"(hi)); return r; }
__device__ __forceinline__ float bflo(unsigned w) { return __uint_as_float(w << 16); }
__device__ __forceinline__ float bfhi(unsigned w) { return __uint_as_float(w & 0xffff0000u); }
__device__ __forceinline__ float sigm(float v) { return __builtin_amdgcn_rcpf(1.0f + __expf(-v)); }
constexpr int ZSW = 6400, ZRW = 7424, ZW = ZSW + ZRW;
constexpr int ZS_MQ = 0, ZS_MK = 512, ZS_MV = 1024, ZS_MO = 2048, ZS_RQ = 3072, ZS_RK = 3584, ZS_RV = 4096, ZS_RG = 5120, ZS_MISC = 6144;
constexpr int ZR_DQ = 0, ZR_DKV = 512, ZR_KR = 1024, ZR_GM = 1280, ZR_GA = 3328, ZR_GR = 5376;

struct EpiBf16 {
    static constexpr bool PERM = true, AFTER_DRAIN = false, HOOK = false;
    bf16_t* O; int ldc; const float* bias; int actmode; int hook_t0, hook_t1; bf16_t* O1 = nullptr; int ldc1 = 0; bf16_t* O2 = nullptr; int ldc2 = 0;
    __device__ __forceinline__ void hook(f32x4 (&acc)[2][2][4][2], const Unit& u, int t, int wr, int wc, int fr, int fq) const {}
    __device__ __forceinline__ void operator()(const f32x4 (&acc)[2][2][4][2], const Unit& u, int wr, int wc, int fr, int fq) const {
        const bool wt = (actmode & 256) != 0; const int actmode_ = actmode & 255;
        int act = 0; { const int pn = u.pn; if (actmode_ == 1) act = (pn >= 8 && pn < 12) ? 1 : ((pn >= 20 && pn < 24) ? 2 : 0); else if (actmode_ == 2) act = pn >= 5 ? 1 : 0; }
        const int row0 = u.pm * BM + wr * 64 + fr; const int col0 = u.pn * BM + wc * 32 + 8 * fq;
        bf16_t* o0_ = O; bf16_t* o1_ = O1; bf16_t* o2_ = O2; int l0_ = ldc, l1_ = ldc1, l2_ = ldc2;
        asm volatile("" : "+s"(o0_), "+s"(o1_), "+s"(o2_), "+s"(l0_), "+s"(l1_), "+s"(l2_));
        bf16_t* Os = u.seg == 0 ? o0_ : (u.seg == 1 ? o1_ : o2_); const int lds_ = u.seg == 0 ? l0_ : (u.seg == 1 ? l1_ : l2_);
        f32x4 bv[2][2];
#pragma unroll
        for (int bj = 0; bj < 2; ++bj)
#pragma unroll
            for (int n = 0; n < 2; ++n) bv[bj][n] = bias ? *(const f32x4*)(bias + col0 + bj * HALF + 4 * n) : (f32x4){0.f, 0.f, 0.f, 0.f};
#pragma unroll
        for (int ai = 0; ai < 2; ++ai)
#pragma unroll
            for (int m = 0; m < 4; ++m) { bf16_t* rowp = Os + (size_t)(row0 + ai * HALF + m * 16) * lds_ + col0;
#pragma unroll
                for (int bj = 0; bj < 2; ++bj) { f32x4 v0 = acc[ai][bj][m][0] + bv[bj][0], v1 = acc[ai][bj][m][1] + bv[bj][1];
                    if (act == 1) {
#pragma unroll
                        for (int k = 0; k < 4; ++k) { v0[k] = sigm(v0[k]); v1[k] = sigm(v1[k]); }
                    } else if (act == 2) {
#pragma unroll
                        for (int k = 0; k < 4; ++k) { v0[k] = v0[k] * sigm(v0[k]); v1[k] = v1[k] * sigm(v1[k]); }
                    }
                    u32x4 w; w.x = cvt_pk_bf16(v0[0], v0[1]); w.y = cvt_pk_bf16(v0[2], v0[3]); w.z = cvt_pk_bf16(v1[0], v1[1]); w.w = cvt_pk_bf16(v1[2], v1[3]);
                    if (wt) asm volatile("global_store_dwordx4 %0, %1, off sc0 sc1" :: "v"(rowp + bj * HALF), "v"(w) : "memory");
                    else *(u32x4*)(rowp + bj * HALF) = w; } }
    }
};

struct EpiUp {
    static constexpr bool PERM = true, AFTER_DRAIN = false, HOOK = true;
    bf16_t* O; int ldc; const bf16_t* Zg; int hook_t0, hook_t1;
    __device__ __forceinline__ void hook(f32x4 (&acc)[2][2][4][2], const Unit& u, int t, int wr, int wc, int fr, int fq) const {
        const int cn = (t == hook_t0) ? ZR_GM : ZR_GA;
        int frl = fr, fql = fq; asm volatile("" : "+v"(frl), "+v"(fql));
        const char* zb = (const char*)(Zg + (size_t)(u.pm * BM + wr * 64) * ZRW + u.pn * BM + wc * 32 + cn);
        const unsigned lo = (unsigned)(frl * ZRW + 8 * fql) * 2u;
#pragma unroll
        for (int ai = 0; ai < 2; ++ai) {
            u32x4 gn[4][2], gd[4][2];
#pragma unroll
            for (int m = 0; m < 4; ++m) { const char* zr = zb + (lo + (unsigned)((ai * HALF + m * 16) * ZRW) * 2u);
#pragma unroll
                for (int bj = 0; bj < 2; ++bj) { gn[m][bj] = *(const u32x4*)(zr + bj * HALF * 2); gd[m][bj] = *(const u32x4*)(zr + 4096 + bj * HALF * 2); } }
#pragma unroll
            for (int m = 0; m < 4; ++m)
#pragma unroll
                for (int bj = 0; bj < 2; ++bj) { const u32x4 a = gn[m][bj], d = gd[m][bj];
                    f32x4 r0, r1;
                    r0[0] = bflo(a.x) * __builtin_amdgcn_rcpf(fmaxf(bflo(d.x), 1e-30f)); r0[1] = bfhi(a.x) * __builtin_amdgcn_rcpf(fmaxf(bfhi(d.x), 1e-30f));
                    r0[2] = bflo(a.y) * __builtin_amdgcn_rcpf(fmaxf(bflo(d.y), 1e-30f)); r0[3] = bfhi(a.y) * __builtin_amdgcn_rcpf(fmaxf(bfhi(d.y), 1e-30f));
                    r1[0] = bflo(a.z) * __builtin_amdgcn_rcpf(fmaxf(bflo(d.z), 1e-30f)); r1[1] = bfhi(a.z) * __builtin_amdgcn_rcpf(fmaxf(bfhi(d.z), 1e-30f));
                    r1[2] = bflo(a.w) * __builtin_amdgcn_rcpf(fmaxf(bflo(d.w), 1e-30f)); r1[3] = bfhi(a.w) * __builtin_amdgcn_rcpf(fmaxf(bfhi(d.w), 1e-30f));
                    acc[ai][bj][m][0] = acc[ai][bj][m][0] * r0; acc[ai][bj][m][1] = acc[ai][bj][m][1] * r1; }
            __builtin_amdgcn_sched_barrier(0);
        }
    }
    __device__ __forceinline__ void operator()(const f32x4 (&acc)[2][2][4][2], const Unit& u, int wr, int wc, int fr, int fq) const {
        const int row0 = u.pm * BM + wr * 64 + fr; const int col0 = u.pn * BM + wc * 32 + 8 * fq;
#pragma unroll
        for (int ai = 0; ai < 2; ++ai)
#pragma unroll
            for (int m = 0; m < 4; ++m) { const size_t rr = (size_t)(row0 + ai * HALF + m * 16); const bf16_t* zr = Zg + rr * ZRW + ZR_GR + col0; bf16_t* rowp = O + rr * ldc + col0;
#pragma unroll
                for (int bj = 0; bj < 2; ++bj) { const u32x4 g = *(const u32x4*)(zr + bj * HALF);
                    f32x4 v0 = acc[ai][bj][m][0], v1 = acc[ai][bj][m][1];
                    v0[0] *= bflo(g.x); v0[1] *= bfhi(g.x); v0[2] *= bflo(g.y); v0[3] *= bfhi(g.y);
                    v1[0] *= bflo(g.z); v1[1] *= bfhi(g.z); v1[2] *= bflo(g.w); v1[3] *= bfhi(g.w);
                    u32x4 w; w.x = cvt_pk_bf16(v0[0], v0[1]); w.y = cvt_pk_bf16(v0[2], v0[3]); w.z = cvt_pk_bf16(v1[0], v1[1]); w.w = cvt_pk_bf16(v1[2], v1[3]);
                    *(u32x4*)(rowp + bj * HALF) = w; }
                if (m == 3) __builtin_amdgcn_sched_barrier(0); }
    }
};

struct EpiStat {
    static constexpr bool PERM = true, AFTER_DRAIN = false, HOOK = false;
    bf16_t* O; int ldc; float* stats; int hook_t0, hook_t1;
    __device__ __forceinline__ void hook(f32x4 (&acc)[2][2][4][2], const Unit& u, int t, int wr, int wc, int fr, int fq) const {}
    __device__ __forceinline__ void operator()(const f32x4 (&acc)[2][2][4][2], const Unit& u, int wr, int wc, int fr, int fq) const {
        const int row0 = u.pm * BM + wr * 64 + fr; const int col0 = u.pn * BM + wc * 32 + 8 * fq;
#pragma unroll
        for (int ai = 0; ai < 2; ++ai)
#pragma unroll
            for (int m = 0; m < 4; ++m) { const size_t rr = (size_t)(row0 + ai * HALF + m * 16); bf16_t* rowp = O + rr * ldc + col0; float s = 0.f;
#pragma unroll
                for (int bj = 0; bj < 2; ++bj) { const f32x4 v0 = acc[ai][bj][m][0], v1 = acc[ai][bj][m][1];
                    s += (v0[0] * v0[0] + v0[1] * v0[1]) + (v0[2] * v0[2] + v0[3] * v0[3]) + (v1[0] * v1[0] + v1[1] * v1[1]) + (v1[2] * v1[2] + v1[3] * v1[3]);
                    u32x4 w; w.x = cvt_pk_bf16(v0[0], v0[1]); w.y = cvt_pk_bf16(v0[2], v0[3]); w.z = cvt_pk_bf16(v1[0], v1[1]); w.w = cvt_pk_bf16(v1[2], v1[3]);
                    *(u32x4*)(rowp + bj * HALF) = w; }
                s += __shfl_xor(s, 16); s += __shfl_xor(s, 32);
                if (fq == 0) stats[(rr * 8 + u.pn) * 4 + wc] = s; }
    }
};

struct EpiSwi {
    static constexpr bool PERM = true, AFTER_DRAIN = false, HOOK = false;
    bf16_t* O; int ldc; int hook_t0, hook_t1;
    __device__ __forceinline__ void hook(f32x4 (&acc)[2][2][4][2], const Unit& u, int t, int wr, int wc, int fr, int fq) const {}
    __device__ __forceinline__ void operator()(const f32x4 (&acc)[2][2][4][2], const Unit& u, int wr, int wc, int fr, int fq) const {
        const int row0 = u.pm * BM + wr * 64 + fr; const int col0 = u.pn * HALF + wc * 32 + 8 * fq;
#pragma unroll
        for (int ai = 0; ai < 2; ++ai)
#pragma unroll
            for (int m = 0; m < 4; ++m) { bf16_t* rowp = O + (size_t)(row0 + ai * HALF + m * 16) * ldc + col0;
                f32x4 a0 = acc[ai][0][m][0], a1 = acc[ai][0][m][1]; const f32x4 g0 = acc[ai][1][m][0], g1 = acc[ai][1][m][1];
#pragma unroll
                for (int k = 0; k < 4; ++k) { a0[k] = a0[k] * g0[k] * sigm(g0[k]); a1[k] = a1[k] * g1[k] * sigm(g1[k]); }
                u32x4 w; w.x = cvt_pk_bf16(a0[0], a0[1]); w.y = cvt_pk_bf16(a0[2], a0[3]); w.z = cvt_pk_bf16(a1[0], a1[1]); w.w = cvt_pk_bf16(a1[2], a1[3]);
                *(u32x4*)rowp = w; }
    }
};

template <class Epi, class Sched, bool ALIGN_EPI = false, bool SP2 = false>
__device__ __forceinline__ void gemm_phase(PG8_LAS unsigned char* lds, const Gemm g, const Sched& S, const Epi& E) {
    int tid_ = threadIdx.x; asm volatile("" : "+v"(tid_));
    const int tid = tid_, wid = __builtin_amdgcn_readfirstlane(tid >> 6), lane = tid & 63, wr = wid >> 2, wc = wid & 3, fr = lane & 15, fq = lane >> 4;
    const int K = g.K, nt = K / BK, LD = g.ld ? g.ld : K;
    unsigned voffA[2], voffB[2];
#pragma unroll
    for (int i = 0; i < 2; ++i) { int R, C; stage_rc(tid * 16 + i * 8192, R, C); const int Rb = Epi::PERM ? ((R & ~31) + perm32(R & 31)) : R;
        voffA[i] = (unsigned)(R * LD + C) * 2u; voffB[i] = (unsigned)(Rb * LD + C) * 2u; }
    const size_t kstep = (size_t)(BK * 2);
    const size_t hstep = (size_t)HALF * LD * 2;
    const size_t tstep = 2 * hstep;
    const unsigned ldsw = (unsigned)wid * 1024u;
    const int aoff = lds_byte(wr * 64 + fr, fq * 8), boff = lds_byte(wc * 32 + fr, fq * 8);
#define PG8_SA(b, h) (((b) * 2 + (h)) * HTB)
#define PG8_SB(b, h) ((4 + (b) * 2 + (h)) * HTB)
#define PG8_STAGE(bufoff, gbase, voff) do { _Pragma("unroll") for (int _i = 0; _i < 2; ++_i) \
        __builtin_amdgcn_global_load_lds((const unsigned*)((const char*)(gbase) + (voff)[_i]), (PG8_LAS unsigned*)(lds + (bufoff) + ldsw + _i * 8192), 16, 0, 0); } while (0)
#define PG8_LDA(dst, b, h) do { _Pragma("unroll") for (int m = 0; m < 4; ++m) _Pragma("unroll") for (int k = 0; k < 2; ++k) dst[m][k] = *(const PG8_LAS bf16x8*)(lds + PG8_SA(b, h) + aoff + m * 2048 + k * 1024); } while (0)
#define PG8_LDB(dst, b, h) do { _Pragma("unroll") for (int n = 0; n < 2; ++n) _Pragma("unroll") for (int k = 0; k < 2; ++k) dst[n][k] = *(const PG8_LAS bf16x8*)(lds + PG8_SB(b, h) + boff + n * 2048 + k * 1024); } while (0)
#define PG8_MMA(ai, bj, At, Bt) do { __builtin_amdgcn_s_setprio(1); _Pragma("unroll") for (int m = 0; m < 4; ++m) _Pragma("unroll") for (int n = 0; n < 2; ++n) _Pragma("unroll") for (int k = 0; k < 2; ++k) \
        acc[ai][bj][m][n] = __builtin_amdgcn_mfma_f32_16x16x32_bf16(Bt[n][k], At[m][k], acc[ai][bj][m][n], 0, 0, 0); __builtin_amdgcn_s_setprio(0); } while (0)
#define PG8_WAIT_V(n) asm volatile("s_waitcnt vmcnt(" #n ")" ::: "memory")
#define PG8_WAIT_L(n) asm volatile("s_waitcnt lgkmcnt(" #n ")" ::: "memory")
#define PG8_BAR __builtin_amdgcn_s_barrier()
#define PG8_SCHED __builtin_amdgcn_sched_barrier(0)
    Unit cur, nxt; int ui = 0;
    if (!S.next(0, cur)) return;
    f32x4 acc[2][2][4][2];
#pragma unroll
    for (int a = 0; a < 2; ++a)
#pragma unroll
        for (int b = 0; b < 2; ++b)
#pragma unroll
            for (int m = 0; m < 4; ++m)
#pragma unroll
                for (int n = 0; n < 2; ++n) acc[a][b][m][n] = (f32x4){0.f, 0.f, 0.f, 0.f};
    bf16x8 At[4][2], B0[2][2], B1[2][2];
    const char* const gA0_ = (const char*)g.A; const char* const gA1_ = (const char*)g.A1; const char* const gA2_ = (const char*)g.A2;
    const char* const gB0_ = (const char*)g.Bt; const char* const gB1_ = (const char*)g.Bt1; const char* const gB2_ = (const char*)g.Bt2;
    const int gnMr_ = g.nMr, gks_ = g.kslice;
    { const char* a0 = gA0_; (void)a0; }
#define PG8_ABASE(u) (((u).seg == 0 ? gA0_ : ((u).seg == 1 ? gA1_ : gA2_)) + (size_t)((u).pm % gnMr_) * tstep + (size_t)((u).pm / gnMr_) * gks_ * 2)
#define PG8_BBASE(u) (((u).seg == 0 ? gB0_ : ((u).seg == 1 ? gB1_ : gB2_)) + (size_t)(u).pn * tstep + (size_t)((u).pm / gnMr_) * gks_ * 2)
    const char* cA = PG8_ABASE(cur); const char* cB = PG8_BBASE(cur);
    S.a_ready(cur);
    if constexpr (SP2) {
        PG8_STAGE(PG8_SB(0, 0), cB, voffB); PG8_STAGE(PG8_SB(0, 1), cB + hstep, voffB); PG8_STAGE(PG8_SA(0, 0), cA, voffA); PG8_STAGE(PG8_SA(0, 1), cA + hstep, voffA);
        if (wr == 1) PG8_BAR;
        PG8_WAIT_V(2); PG8_BAR;
        PG8_STAGE(PG8_SB(1, 0), cB + kstep, voffB); PG8_STAGE(PG8_SA(1, 0), cA + kstep, voffA); PG8_STAGE(PG8_SB(1, 1), cB + hstep + kstep, voffB);
        PG8_WAIT_V(6); PG8_BAR;
    } else {
        PG8_STAGE(PG8_SB(0, 0), cB, voffB); PG8_STAGE(PG8_SA(0, 0), cA, voffA); PG8_STAGE(PG8_SB(0, 1), cB + hstep, voffB); PG8_STAGE(PG8_SA(0, 1), cA + hstep, voffA);
        if (wr == 1) PG8_BAR;
        PG8_WAIT_V(4); PG8_BAR;
        PG8_STAGE(PG8_SB(1, 0), cB + kstep, voffB); PG8_STAGE(PG8_SA(1, 0), cA + kstep, voffA); PG8_STAGE(PG8_SB(1, 1), cB + hstep + kstep, voffB);
        PG8_WAIT_V(6); PG8_BAR;
    }
    for (;;) {
        const bool has_next = S.next(ui + 1, nxt);
        const char* nA = has_next ? PG8_ABASE(nxt) : cA; const char* nB = has_next ? PG8_BBASE(nxt) : cB;
        for (int t = 0; t < nt; t += 2) {
            if constexpr (Epi::HOOK) { if (t == E.hook_t0 || t == E.hook_t1) E.hook(acc, cur, t, wr, wc, fr, fq); }
            const bool last = (t == nt - 2);
            const char* a1 = cA + (size_t)(t + 1) * kstep;
            const char* a2 = last ? nA : cA + (size_t)(t + 2) * kstep; const char* b2 = last ? nB : cB + (size_t)(t + 2) * kstep;
            const char* a3 = a2 + kstep; const char* b3 = b2 + kstep;
            if (last && has_next) S.a_ready(nxt);
            if constexpr (SP2) {
            PG8_LDB(B0, 0, 0); PG8_LDB(B1, 0, 1); PG8_SCHED; PG8_LDA(At, 0, 0); PG8_STAGE(PG8_SA(1, 1), a1 + hstep, voffA);
            PG8_WAIT_V(8); PG8_WAIT_L(0); PG8_BAR; PG8_MMA(0, 0, At, B0); PG8_MMA(0, 1, At, B1); PG8_BAR; PG8_SCHED;
            PG8_LDA(At, 0, 1); PG8_STAGE(PG8_SB(0, 0), b2, voffB); PG8_STAGE(PG8_SB(0, 1), b2 + hstep, voffB); PG8_STAGE(PG8_SA(0, 0), a2, voffA);
            PG8_WAIT_V(8); PG8_WAIT_L(0); PG8_BAR; PG8_MMA(1, 0, At, B0); PG8_MMA(1, 1, At, B1); PG8_BAR; PG8_SCHED;
            PG8_LDB(B0, 1, 0); PG8_LDB(B1, 1, 1); PG8_SCHED; PG8_LDA(At, 1, 0); PG8_STAGE(PG8_SA(0, 1), a2 + hstep, voffA);
            PG8_WAIT_V(8); PG8_WAIT_L(0); PG8_BAR; PG8_MMA(0, 0, At, B0); PG8_MMA(0, 1, At, B1); PG8_BAR; PG8_SCHED;
            PG8_LDA(At, 1, 1); PG8_STAGE(PG8_SB(1, 0), b3, voffB); PG8_STAGE(PG8_SB(1, 1), b3 + hstep, voffB); PG8_STAGE(PG8_SA(1, 0), a3, voffA);
            PG8_WAIT_V(8); PG8_WAIT_L(0); PG8_BAR; PG8_MMA(1, 0, At, B0); PG8_MMA(1, 1, At, B1); PG8_BAR; PG8_SCHED;
            } else {
            PG8_LDB(B0, 0, 0); PG8_SCHED; PG8_LDA(At, 0, 0); PG8_STAGE(PG8_SA(1, 1), a1 + hstep, voffA);
            PG8_WAIT_L(8); PG8_BAR; PG8_WAIT_L(0); PG8_MMA(0, 0, At, B0); PG8_BAR; PG8_SCHED;
            PG8_LDB(B1, 0, 1); PG8_STAGE(PG8_SB(0, 0), b2, voffB);
            PG8_BAR; PG8_WAIT_L(0); PG8_MMA(0, 1, At, B1); PG8_BAR;
            PG8_LDA(At, 0, 1); PG8_STAGE(PG8_SA(0, 0), a2, voffA);
            PG8_BAR; PG8_WAIT_L(0); PG8_MMA(1, 0, At, B0); PG8_BAR; PG8_SCHED;
            PG8_STAGE(PG8_SB(0, 1), b2 + hstep, voffB);
            PG8_WAIT_V(6); PG8_BAR; PG8_MMA(1, 1, At, B1); PG8_BAR;
            PG8_LDB(B0, 1, 0); PG8_SCHED; PG8_LDA(At, 1, 0); PG8_STAGE(PG8_SA(0, 1), a2 + hstep, voffA);
            PG8_WAIT_L(8); PG8_BAR; PG8_WAIT_L(0); PG8_MMA(0, 0, At, B0); PG8_BAR; PG8_SCHED;
            PG8_LDB(B1, 1, 1); PG8_STAGE(PG8_SB(1, 0), b3, voffB);
            PG8_BAR; PG8_WAIT_L(0); PG8_MMA(0, 1, At, B1); PG8_BAR;
            PG8_LDA(At, 1, 1); PG8_STAGE(PG8_SA(1, 0), a3, voffA);
            PG8_BAR; PG8_WAIT_L(0); PG8_MMA(1, 0, At, B0); PG8_BAR; PG8_SCHED;
            PG8_STAGE(PG8_SB(1, 1), b3 + hstep, voffB);
            PG8_WAIT_V(6); PG8_BAR; PG8_MMA(1, 1, At, B1); PG8_BAR;
            }
        }
        if constexpr (ALIGN_EPI) { if (wr == 0) PG8_BAR; }
        if constexpr (!Epi::AFTER_DRAIN) { E(acc, cur, wr, wc, fr, fq); S.done(cur); }
        if (!has_next) break;
#pragma unroll
        for (int a = 0; a < 2; ++a)
#pragma unroll
            for (int b = 0; b < 2; ++b)
#pragma unroll
                for (int m = 0; m < 4; ++m)
#pragma unroll
                    for (int n = 0; n < 2; ++n) acc[a][b][m][n] = (f32x4){0.f, 0.f, 0.f, 0.f};
        cur = nxt; cA = nA; cB = nB; ++ui;
        if constexpr (ALIGN_EPI) { if (wr == 1) PG8_BAR; }
    }
    PG8_WAIT_V(0);
    if constexpr (!ALIGN_EPI) { if (wr == 0) PG8_BAR; }
    PG8_BAR;
    if constexpr (Epi::AFTER_DRAIN) { E.fused(acc, cur, wr, wc, fr, fq, lds, wid, lane); S.done(cur); }
#undef PG8_ABASE
#undef PG8_BBASE
#undef PG8_SA
#undef PG8_SB
#undef PG8_STAGE
#undef PG8_LDA
#undef PG8_LDB
#undef PG8_MMA
#undef PG8_WAIT_V
#undef PG8_WAIT_L
#undef PG8_BAR
#undef PG8_SCHED
}
}

#define GAS __attribute__((address_space(1)))
#define LAS __attribute__((address_space(3)))
typedef unsigned short bf16;
typedef unsigned v4u __attribute__((ext_vector_type(4)));
typedef unsigned v2u __attribute__((ext_vector_type(2)));
typedef float f32x4 __attribute__((ext_vector_type(4)));
typedef float f32x16 __attribute__((ext_vector_type(16)));
typedef short bf16x8 __attribute__((ext_vector_type(8)));
typedef short s16x4 __attribute__((ext_vector_type(4)));
typedef short v4i16_t __attribute__((ext_vector_type(4)));
#define MFMA32(a, b, c) __builtin_amdgcn_mfma_f32_32x32x16_bf16((a), (b), (c), 0, 0, 0)
using pg8::ZSW; using pg8::ZRW; using pg8::ZW; using pg8::ZS_MQ; using pg8::ZS_MK; using pg8::ZS_MV; using pg8::ZS_MO; using pg8::ZS_RQ; using pg8::ZS_RK; using pg8::ZS_RV; using pg8::ZS_RG; using pg8::ZS_MISC; using pg8::ZR_DQ; using pg8::ZR_DKV; using pg8::ZR_KR; using pg8::ZR_GM; using pg8::ZR_GA; using pg8::ZR_GR;

constexpr int NWAVES = 8, NTHR = 512;
constexpr int DM = 2048, NBATCH = 8, SEQ = 4096, DSEQ = 64, PAST = 1024, DFF = 5632, DIN = 13384;
constexpr int MP = NBATCH * SEQ, MS = NBATCH * DSEQ, MT = MP + MS;
constexpr float EPS = 1e-6f;
constexpr int YW = 3072;
__device__ __forceinline__ int grp_row0(int g) { return g * 12288; }
__device__ __forceinline__ int grp_rows(int g) { return g < 2 ? 12288 : 8704; }
__device__ __forceinline__ int grp_ck(int g) { return g < 2 ? 12288 : 16896; }
constexpr int GROWS_MAX = 12288, GCK_MAX = 16896;

constexpr size_t MiB = 1u << 20;
constexpr size_t WS_CTL = 0;
constexpr size_t WS_ROPEA = 1 * MiB;
constexpr size_t WS_ROPER = 2 * MiB;
constexpr size_t WS_W = 4 * MiB, W_LAYER = 144 * MiB;
constexpr size_t WO_IN = 0, WO_GU = WO_IN + (size_t)ZW * DM * 2, WO_DOWN = WO_GU + (size_t)2 * DFF * DM * 2, WO_O = WO_DOWN + (size_t)DM * DFF * 2,
                 WO_UP = WO_O + (size_t)DM * DM * 2, WO_UQ = WO_UP + (size_t)DM * YW * 2, WO_UK = WO_UQ + (size_t)1536 * 512 * 2, WO_V = WO_UK + (size_t)1024 * 512 * 2,
                 WO_BIAS = WO_V + (size_t)1024 * 512 * 2, WO_END = WO_BIAS + (size_t)ZW * 4;
static_assert(WO_END <= W_LAYER, "weights per layer");
constexpr size_t WS_XB = WS_W + 2 * W_LAYER;
constexpr size_t WS_G = WS_XB + (size_t)MT * DM * 2;
constexpr size_t GO_ZS = 0, GO_ZS_END = (size_t)MT * ZSW * 2;
constexpr size_t GO_Z = 0, GO_QA = GO_Z + (size_t)GROWS_MAX * ZRW * 2, GO_QN = GO_QA + (size_t)GROWS_MAX * 1536 * 2, GO_CK = GO_QN + (size_t)GROWS_MAX * 512 * 2,
                 GO_KR = GO_CK + (size_t)GCK_MAX * 512 * 2, GO_KN = GO_KR + (size_t)GCK_MAX * 64 * 2, GO_VT = GO_KN + (size_t)GCK_MAX * 1024 * 2, GO_GEND = GO_VT + (size_t)GCK_MAX * 1024 * 2;
static_assert(GO_GEND <= GO_ZS_END, "group buffers overlay Zs");
constexpr size_t GO_Y = GO_ZS_END, GO_END = GO_Y + (size_t)MT * YW * 2;
constexpr size_t GO_ACT = 0, GO_MIX = (size_t)MT * DFF * 2, GO_TP = GO_MIX + (size_t)MT * DM * 2;
static_assert(GO_TP + (size_t)11 * MS * DM * 2 <= GO_END, "overlay");
constexpr size_t WS_END = WS_G + GO_END;
static_assert(WS_END <= (size_t)1024 * MiB, "ws");

constexpr int LDS_BYTES = 147456;
constexpr int MISC_OFF = 131072;

__device__ __forceinline__ float bf2f(unsigned short b) { return __uint_as_float((unsigned)b << 16); }
typedef __bf16 hwbf2 __attribute__((ext_vector_type(2)));
typedef float hwf2 __attribute__((ext_vector_type(2)));
__device__ __forceinline__ unsigned pk2(float lo, float hi) { hwf2 v = {lo, hi}; return __builtin_bit_cast(unsigned, __builtin_convertvector(v, hwbf2)); }
__device__ __forceinline__ unsigned f2bf(float f) { return pk2(f, 0.f) & 0xffffu; }
__device__ __forceinline__ float blo(unsigned w) { return __uint_as_float(w << 16); }
__device__ __forceinline__ float bhi(unsigned w) { return __uint_as_float(w & 0xffff0000u); }
template <int CTRL> __device__ __forceinline__ float dppf(float v) { return __int_as_float(__builtin_amdgcn_update_dpp(0, __float_as_int(v), CTRL, 0xf, 0xf, true)); }
__device__ __forceinline__ float wave_sum(float v) {
    v += dppf<0xB1>(v);
    v += dppf<0x4E>(v);
    v += dppf<0x141>(v);
    v += dppf<0x140>(v);
    v += __shfl_xor(v, 16); v += __shfl_xor(v, 32);
    return v;
}
template <int CTRL> __device__ __forceinline__ float dppk(float old, float v) { return __int_as_float(__builtin_amdgcn_update_dpp(__float_as_int(old), __float_as_int(v), CTRL, 0xf, 0xf, false)); }
__device__ __forceinline__ float rdlane(float v, int l) { return __int_as_float(__builtin_amdgcn_readlane(__float_as_int(v), l)); }
__device__ __forceinline__ int crow(int i, int hh) { return (i & 3) + 8 * (i >> 2) + 4 * hh; }
__device__ __forceinline__ bf16x8 pack8(float a0, float a1, float a2, float a3, float a4, float a5, float a6, float a7) {
    v4u p; p.x = pk2(a0, a1); p.y = pk2(a2, a3); p.z = pk2(a4, a5); p.w = pk2(a6, a7); return __builtin_bit_cast(bf16x8, p);
}
__device__ __forceinline__ s16x4 trrd(const LAS unsigned char* p) { return __builtin_bit_cast(s16x4, __builtin_amdgcn_ds_read_tr16_b64_v4i16((LAS v4i16_t*)p)); }
__device__ __forceinline__ bf16x8 cat4(s16x4 lo, s16x4 hi) { return __builtin_shufflevector(lo, hi, 0, 1, 2, 3, 4, 5, 6, 7); }

struct Args { const float* in[26]; float* out; unsigned char* ws; int ph_lo, ph_hi; };

constexpr size_t O_YP = 0, O_YS = O_YP + (size_t)MP * DM, O_PCKV = O_YS + (size_t)MS * DM, O_PKR = O_PCKV + (size_t)2 * MP * 512, O_PC = O_PKR + (size_t)2 * MP * 64,
                 O_PN = O_PC + (size_t)2 * 8 * 4 * 256 * 128, O_PM = O_PN + (size_t)2 * 8 * 4 * 128, O_PR = O_PM + 64, O_SCKV = O_PR + (size_t)2 * 8 * 4 * 128 * 256,
                 O_SKR = O_SCKV + (size_t)2 * MS * 512, O_SC = O_SKR + (size_t)2 * MS * 64, O_SN = O_SC + (size_t)2 * 8 * 4 * 256 * 128, O_SM = O_SN + (size_t)2 * 8 * 4 * 128,
                 O_SR = O_SM + 64, O_END = O_SR + (size_t)2 * 8 * 4 * 128 * 256;

__device__ __forceinline__ int zsrc(int n) {
    if (n < 3072) return n;
    if (n < 6144) return n - 3072 + 4168;
    if (n < 6400) { const int j = n - 6144; return j < 8 ? 3072 + j : -1; }
    const int m = n - 6400;
    if (m < 1024) return 3080 + m;
    if (m < 1280) { const int j = m - 1024; return j < 64 ? 4104 + j : -1; }
    return 7240 + (m - 1280);
}
__device__ __forceinline__ int srccol(int mode, int n) {
    switch (mode) {
        case 0: return zsrc(n);
        case 1: return ((n & 255) < 128) ? 128 * (n >> 8) + (n & 127) : DFF + 128 * (n >> 8) + (n & 127);
        case 3: return (n >> 7) * 256 + (n & 127);
        case 4: return (n >> 7) * 256 + 128 + (n & 127);
        default: return n;
    }
}
__device__ __forceinline__ void transpose_item(const float* W, int Nsrc, bf16* WT, int ldd, int koff, int mode, int nblk, LAS float* scr, int item, int lane) {
    const int kb = item / nblk, nb = item % nblk, k0 = 64 * kb, n0 = 32 * nb;
    const int sc = srccol(mode, n0 + (lane & 31));
    float wv[32];
#pragma unroll
    for (int i = 0; i < 32; ++i) { const int kk = 2 * i + (lane >> 5); wv[i] = sc >= 0 ? __builtin_nontemporal_load(W + (size_t)(k0 + kk) * Nsrc + sc) : 0.f; }
#pragma unroll
    for (int i = 0; i < 32; ++i) { const int kk = 2 * i + (lane >> 5); scr[kk * 33 + (lane & 31)] = wv[i]; }
    asm volatile("s_waitcnt lgkmcnt(0)" ::: "memory");
    const int c = lane & 7;
#pragma unroll
    for (int j = 0; j < 4; ++j) { const int n = (lane >> 3) + 8 * j; const LAS float* s = scr + (8 * c) * 33 + n;
        v4u o; o.x = pk2(s[0 * 33], s[1 * 33]); o.y = pk2(s[2 * 33], s[3 * 33]); o.z = pk2(s[4 * 33], s[5 * 33]); o.w = pk2(s[6 * 33], s[7 * 33]);
        *(v4u*)(WT + (size_t)(n0 + n) * ldd + koff + k0 + 8 * c) = o; }
    asm volatile("s_waitcnt lgkmcnt(0)" ::: "memory");
}
__device__ __forceinline__ void rms_row2_to_bf16(const float* xa, const float* xb, const float* g, bf16* oa, bf16* ob, int lane) {
    f32x4 va[8], vb[8]; float sa = 0.f, sb = 0.f;
#pragma unroll
    for (int j = 0; j < 8; ++j) { va[j] = __builtin_nontemporal_load((const f32x4*)(xa + 4 * lane + 256 * j)); vb[j] = __builtin_nontemporal_load((const f32x4*)(xb + 4 * lane + 256 * j)); }
#pragma unroll
    for (int j = 0; j < 8; ++j) { sa += (va[j].x * va[j].x + va[j].y * va[j].y) + (va[j].z * va[j].z + va[j].w * va[j].w); sb += (vb[j].x * vb[j].x + vb[j].y * vb[j].y) + (vb[j].z * vb[j].z + vb[j].w * vb[j].w); }
    const float ra = rsqrtf(wave_sum(sa) * (1.f / DM) + EPS), rb = rsqrtf(wave_sum(sb) * (1.f / DM) + EPS);
#pragma unroll
    for (int j = 0; j < 8; ++j) { const f32x4 gg = *(const f32x4*)(g + 4 * lane + 256 * j);
        v2u o; o.x = pk2(va[j].x * ra * gg.x, va[j].y * ra * gg.y); o.y = pk2(va[j].z * ra * gg.z, va[j].w * ra * gg.w); *(v2u*)(oa + 4 * lane + 256 * j) = o;
        v2u q; q.x = pk2(vb[j].x * rb * gg.x, vb[j].y * rb * gg.y); q.y = pk2(vb[j].z * rb * gg.z, vb[j].w * rb * gg.w); *(v2u*)(ob + 4 * lane + 256 * j) = q; }
}
__device__ __forceinline__ void rms_row_to_bf16(const float* xrow, const float* g, bf16* orow, int lane) {
    f32x4 v[8]; float s = 0.f;
#pragma unroll
    for (int j = 0; j < 8; ++j) { v[j] = __builtin_nontemporal_load((const f32x4*)(xrow + 4 * lane + 256 * j)); s += (v[j].x * v[j].x + v[j].y * v[j].y) + (v[j].z * v[j].z + v[j].w * v[j].w); }
    const float r = rsqrtf(wave_sum(s) * (1.f / DM) + EPS);
#pragma unroll
    for (int j = 0; j < 8; ++j) { const f32x4 gg = *(const f32x4*)(g + 4 * lane + 256 * j);
        v2u o; o.x = pk2(v[j].x * r * gg.x, v[j].y * r * gg.y); o.y = pk2(v[j].z * r * gg.z, v[j].w * r * gg.w); *(v2u*)(orow + 4 * lane + 256 * j) = o; }
}

struct Ctx {
    LAS unsigned char* lds; int tid, lane, wave, G, bid;
    float* out; unsigned char* ws;
};
__device__ __forceinline__ const float* cin(const Ctx& C, int i) {
    const LAS unsigned* p = (const LAS unsigned*)(C.lds + MISC_OFF + 64 + 8 * i);
    const unsigned lo = __builtin_amdgcn_readfirstlane(p[0]), hi = __builtin_amdgcn_readfirstlane(p[1]);
    return (const float*)(((unsigned long long)hi << 32) | lo);
}
#define WPTR(layer, off) ((bf16*)(C.ws + WS_W + (size_t)(layer) * W_LAYER + (off)))
#define GPTR(off) ((bf16*)(C.ws + WS_G + (off)))

constexpr int W_I_IN = (DM / 64) * (ZW / 32), W_I_GU = (DM / 64) * (2 * DFF / 32), W_I_DN = (DFF / 64) * (DM / 32), W_I_O = (DM / 64) * (DM / 32), W_I_UP = (1024 / 64) * (DM / 32),
              W_I_UQ = (512 / 64) * (1536 / 32), W_I_UK = (512 / 64) * (1024 / 32);
constexpr int W_NITEMS = W_I_IN + W_I_GU + W_I_DN + W_I_O + 3 * W_I_UP + W_I_UQ + 2 * W_I_UK;
__device__ __forceinline__ void weight_item(Ctx& C, int layer, int it, LAS float* scr) {
    int r = it;
    if (r < W_I_IN) { transpose_item(cin(C, 9) + (size_t)layer * DM * DIN, DIN, WPTR(layer, WO_IN), DM, 0, 0, ZW / 32, scr, r, C.lane); return; } r -= W_I_IN;
    if (r < W_I_GU) { transpose_item(cin(C, 23) + (size_t)layer * DM * 2 * DFF, 2 * DFF, WPTR(layer, WO_GU), DM, 0, 1, 2 * DFF / 32, scr, r, C.lane); return; } r -= W_I_GU;
    if (r < W_I_DN) { transpose_item(cin(C, 24) + (size_t)layer * DFF * DM, DM, WPTR(layer, WO_DOWN), DFF, 0, 2, DM / 32, scr, r, C.lane); return; } r -= W_I_DN;
    if (r < W_I_O) { transpose_item(cin(C, 20) + (size_t)layer * DM * DM, DM, WPTR(layer, WO_O), DM, 0, 2, DM / 32, scr, r, C.lane); return; } r -= W_I_O;
    if (r < W_I_UP) { transpose_item(cin(C, 12) + (size_t)layer * 1024 * DM, DM, WPTR(layer, WO_UP), YW, 0, 2, DM / 32, scr, r, C.lane); return; } r -= W_I_UP;
    if (r < W_I_UP) { transpose_item(cin(C, 17) + (size_t)layer * 1024 * DM, DM, WPTR(layer, WO_UP), YW, 1024, 2, DM / 32, scr, r, C.lane); return; } r -= W_I_UP;
    if (r < W_I_UP) { transpose_item(cin(C, 19) + (size_t)layer * 1024 * DM, DM, WPTR(layer, WO_UP), YW, 2048, 2, DM / 32, scr, r, C.lane); return; } r -= W_I_UP;
    if (r < W_I_UQ) { transpose_item(cin(C, 14) + (size_t)layer * 512 * 1536, 1536, WPTR(layer, WO_UQ), 512, 0, 2, 1536 / 32, scr, r, C.lane); return; } r -= W_I_UQ;
    if (r < W_I_UK) { transpose_item(cin(C, 16) + (size_t)layer * 512 * 2048, 2048, WPTR(layer, WO_UK), 512, 0, 3, 1024 / 32, scr, r, C.lane); return; } r -= W_I_UK;
    transpose_item(cin(C, 16) + (size_t)layer * 512 * 2048, 2048, WPTR(layer, WO_V), 512, 0, 4, 1024 / 32, scr, r, C.lane);
}

__device__ __forceinline__ void p0_prologue(Ctx& C) {
    asm volatile("" : "+v"(C.lane)); C.tid = C.wave * 64 + C.lane;
    LAS float* scr = (LAS float*)(C.lds + C.wave * 16384);
    int gw = C.bid * NWAVES + C.wave; const int NGW = C.G * NWAVES;
    for (int it = gw; it < W_I_IN + W_I_UQ + 2 * W_I_UK; it += NGW) weight_item(C, 0, it < W_I_IN ? it : it - W_I_IN + (W_NITEMS - W_I_UQ - 2 * W_I_UK), scr);
    for (int layer = 0; layer < 2; ++layer) {
        float* bz = (float*)(C.ws + WS_W + (size_t)layer * W_LAYER + WO_BIAS);
        for (int n = C.bid * NTHR + C.tid; n < ZW; n += C.G * NTHR) { const int s = zsrc(n); bz[n] = s >= 0 ? cin(C, 10)[(size_t)layer * DIN + s] : 0.f; }
    }
    {
        float* ca = (float*)(C.ws + WS_ROPEA); float* sa = ca + 4096 * 32; float* cr = (float*)(C.ws + WS_ROPER); float* sr = cr + 4096 * 64;
        for (int e = C.bid * NTHR + C.tid; e < 4096 * 96; e += C.G * NTHR) {
            int pos, i, d; float* cp; float* sp;
            if (e < 4096 * 32) { pos = e >> 5; i = e & 31; d = 64; cp = ca + e; sp = sa + e; } else { const int e2 = e - 4096 * 32; pos = e2 >> 6; i = e2 & 63; d = 128; cp = cr + e2; sp = sr + e2; }
            const float inv = 1.0f / powf(10000.0f, (float)(2 * i) / (float)d);
            const float ang = (float)pos * inv;
            const double a = (double)ang; const double k = rint(a * 0.15915494309189535); const double red = a - k * 6.283185307179586;
            const float rf = (float)red;
            *cp = __cosf(rf); *sp = __sinf(rf);
        }
    }
    bf16* XB = (bf16*)(C.ws + WS_XB);
    for (int m = gw; m < MT; m += 2 * NGW) {
        const int m2 = m + NGW; const bool has2 = m2 < MT;
        const float* xr = m < MP ? cin(C, 0) + (size_t)m * DM : cin(C, 1) + (size_t)(m - MP) * DM;
        const float* xr2 = has2 ? (m2 < MP ? cin(C, 0) + (size_t)m2 * DM : cin(C, 1) + (size_t)(m2 - MP) * DM) : xr;
        rms_row2_to_bf16(xr, xr2, cin(C, 8), XB + (size_t)m * DM, XB + (size_t)(has2 ? m2 : m) * DM, C.lane); }
}

__device__ __forceinline__ void pe_phase(Ctx& C, int layer, int g) {
    asm volatile("" : "+v"(C.lane)); C.tid = C.wave * 64 + C.lane;
    const int gw = C.bid * NWAVES + C.wave, NGW = C.G * NWAVES, lane = C.lane;
    const bf16* Z = GPTR(GO_Z); bf16* QN = GPTR(GO_QN); bf16* CK = GPTR(GO_CK); bf16* KR = GPTR(GO_KR);
    const float* gqa = cin(C, 13) + layer * 512; const float* gkv = cin(C, 15) + layer * 512;
    const float* ca = (const float*)(C.ws + WS_ROPEA); const float* sa = ca + 4096 * 32;
    const int rows = grp_rows(g), r0 = grp_row0(g);
    for (int lr = gw; lr < rows; lr += NGW) {
        const int m = r0 + lr; const bool smp = m >= MP;
        const int b = smp ? (m - MP) >> 6 : m >> 12, s = smp ? (m - MP) & 63 : m & 4095, pos = smp ? PAST + s : s;
        const int ckrow = smp ? 16384 + (m - MP) : lr;
        const bf16* zr = Z + (size_t)lr * ZRW;
        {
            const v4u w = *(const v4u*)(zr + ZR_DQ + 8 * lane);
            float v[8] = {blo(w.x), bhi(w.x), blo(w.y), bhi(w.y), blo(w.z), bhi(w.z), blo(w.w), bhi(w.w)}; float ss = 0.f;
#pragma unroll
            for (int k = 0; k < 8; ++k) ss += v[k] * v[k];
            const float r = rsqrtf(wave_sum(ss) * (1.f / 512.f) + EPS);
            const f32x4 g0 = *(const f32x4*)(gqa + 8 * lane), g1 = *(const f32x4*)(gqa + 8 * lane + 4);
            v4u o; o.x = pk2(v[0] * r * g0.x, v[1] * r * g0.y); o.y = pk2(v[2] * r * g0.z, v[3] * r * g0.w); o.z = pk2(v[4] * r * g1.x, v[5] * r * g1.y); o.w = pk2(v[6] * r * g1.z, v[7] * r * g1.w);
            *(v4u*)(QN + (size_t)lr * 512 + 8 * lane) = o;
        }
        {
            const v4u w = *(const v4u*)(zr + ZR_DKV + 8 * lane);
            float v[8] = {blo(w.x), bhi(w.x), blo(w.y), bhi(w.y), blo(w.z), bhi(w.z), blo(w.w), bhi(w.w)}; float ss = 0.f;
#pragma unroll
            for (int k = 0; k < 8; ++k) ss += v[k] * v[k];
            const float r = rsqrtf(wave_sum(ss) * (1.f / 512.f) + EPS);
            const f32x4 g0 = *(const f32x4*)(gkv + 8 * lane), g1 = *(const f32x4*)(gkv + 8 * lane + 4);
            f32x4 o0 = {v[0] * r * g0.x, v[1] * r * g0.y, v[2] * r * g0.z, v[3] * r * g0.w}, o1 = {v[4] * r * g1.x, v[5] * r * g1.y, v[6] * r * g1.z, v[7] * r * g1.w};
            float* op = smp ? C.out + O_SCKV + ((size_t)(layer * 8 + b) * DSEQ + s) * 512 : C.out + O_PCKV + ((size_t)(layer * 8 + b) * SEQ + s) * 512;
            __builtin_nontemporal_store(o0, (f32x4*)(op + 8 * lane)); __builtin_nontemporal_store(o1, (f32x4*)(op + 8 * lane + 4));
            v4u o; o.x = pk2(o0.x, o0.y); o.y = pk2(o0.z, o0.w); o.z = pk2(o1.x, o1.y); o.w = pk2(o1.z, o1.w);
            *(v4u*)(CK + (size_t)ckrow * 512 + 8 * lane) = o;
        }
        if (lane < 32) {
            const float x1 = bf2f(zr[ZR_KR + lane]), x2 = bf2f(zr[ZR_KR + 32 + lane]);
            const float c = ca[pos * 32 + lane], sn = sa[pos * 32 + lane];
            const float o1 = x1 * c - x2 * sn, o2 = x1 * sn + x2 * c;
            float* op = smp ? C.out + O_SKR + ((size_t)(layer * 8 + b) * DSEQ + s) * 64 : C.out + O_PKR + ((size_t)(layer * 8 + b) * SEQ + s) * 64;
            op[lane] = o1; op[32 + lane] = o2;
            KR[(size_t)ckrow * 64 + lane] = (bf16)f2bf(o1); KR[(size_t)ckrow * 64 + 32 + lane] = (bf16)f2bf(o2);
        }
    }
    if (g == 2) {
        const float* cc = cin(C, 2) + (size_t)layer * 8 * PAST * 512; const float* ck = cin(C, 3) + (size_t)layer * 8 * PAST * 64;
        { const size_t st = (size_t)C.G * NTHR, n = (size_t)8192 * 128;
          for (size_t e = (size_t)C.bid * NTHR + C.tid; e < n; e += 4 * st) { f32x4 v[4];
#pragma unroll
              for (int u = 0; u < 4; ++u) if (e + u * st < n) v[u] = __builtin_nontemporal_load((const f32x4*)(cc + (e + u * st) * 4));
#pragma unroll
              for (int u = 0; u < 4; ++u) if (e + u * st < n) { v2u o; o.x = pk2(v[u].x, v[u].y); o.y = pk2(v[u].z, v[u].w); *(v2u*)(CK + (size_t)8192 * 512 + (e + u * st) * 4) = o; } } }
        for (size_t e = (size_t)C.bid * NTHR + C.tid; e < (size_t)8192 * 16; e += (size_t)C.G * NTHR) { const f32x4 v = __builtin_nontemporal_load((const f32x4*)(ck + e * 4)); v2u o; o.x = pk2(v.x, v.y); o.y = pk2(v.z, v.w); *(v2u*)(KR + (size_t)8192 * 64 + e * 4) = o; }
    }
}

__device__ __forceinline__ void px_phase(Ctx& C, const bf16* T, const bf16* TP, int nsplit, const float* gpost, const float* gnext, bool first_layer_input) {
    asm volatile("" : "+v"(C.lane)); C.tid = C.wave * 64 + C.lane;
    const int gw = C.bid * NWAVES + C.wave, NGW = C.G * NWAVES, lane = C.lane;
    bf16* XB = (bf16*)(C.ws + WS_XB);
    int m0 = gw;
    if (((MP / NGW) & 1) == 0 && (MP % NGW) == 0) {
        for (; m0 < MP; m0 += 2 * NGW) {
            f32x4 t[2][8], x[2][8];
#pragma unroll
            for (int rr = 0; rr < 2; ++rr) { const int m = m0 + rr * NGW;
                const float* xr = first_layer_input ? cin(C, 0) + (size_t)m * DM : C.out + (size_t)m * DM;
#pragma unroll
                for (int j = 0; j < 8; ++j) { const v2u w = __builtin_nontemporal_load((const v2u*)(T + (size_t)m * DM + 4 * lane + 256 * j)); t[rr][j] = (f32x4){blo(w.x), bhi(w.x), blo(w.y), bhi(w.y)};
                    x[rr][j] = __builtin_nontemporal_load((const f32x4*)(xr + 4 * lane + 256 * j)); } }
#pragma unroll
            for (int rr = 0; rr < 2; ++rr) { const int m = m0 + rr * NGW; float* xo = C.out + (size_t)m * DM; float ts = 0.f;
#pragma unroll
                for (int j = 0; j < 8; ++j) ts += (t[rr][j].x * t[rr][j].x + t[rr][j].y * t[rr][j].y) + (t[rr][j].z * t[rr][j].z + t[rr][j].w * t[rr][j].w);
                const float r = rsqrtf(wave_sum(ts) * (1.f / DM) + EPS); float ss = 0.f;
#pragma unroll
                for (int j = 0; j < 8; ++j) { const int idx = 4 * lane + 256 * j; const f32x4 gg = *(const f32x4*)(gpost + idx); f32x4 v;
                    v.x = x[rr][j].x + t[rr][j].x * r * gg.x; v.y = x[rr][j].y + t[rr][j].y * r * gg.y; v.z = x[rr][j].z + t[rr][j].z * r * gg.z; v.w = x[rr][j].w + t[rr][j].w * r * gg.w;
                    __builtin_nontemporal_store(v, (f32x4*)(xo + idx)); t[rr][j] = v; ss += (v.x * v.x + v.y * v.y) + (v.z * v.z + v.w * v.w); }
                if (gnext) { const float r2 = rsqrtf(wave_sum(ss) * (1.f / DM) + EPS);
#pragma unroll
                    for (int j = 0; j < 8; ++j) { const int idx = 4 * lane + 256 * j; const f32x4 gg = *(const f32x4*)(gnext + idx);
                        v2u o; o.x = pk2(t[rr][j].x * r2 * gg.x, t[rr][j].y * r2 * gg.y); o.y = pk2(t[rr][j].z * r2 * gg.z, t[rr][j].w * r2 * gg.w); *(v2u*)(XB + (size_t)m * DM + idx) = o; } } }
        }
    }
    for (int m = m0; m < MT; m += NGW) {
        const float* xr = first_layer_input ? (m < MP ? cin(C, 0) + (size_t)m * DM : cin(C, 1) + (size_t)(m - MP) * DM) : C.out + (size_t)m * DM;
        float* xo = C.out + (size_t)m * DM;
        f32x4 t[8]; float ts = 0.f;
        if (m < MP) {
#pragma unroll
            for (int j = 0; j < 8; ++j) { const v2u w = __builtin_nontemporal_load((const v2u*)(T + (size_t)m * DM + 4 * lane + 256 * j)); t[j] = (f32x4){blo(w.x), bhi(w.x), blo(w.y), bhi(w.y)}; }
        } else {
#pragma unroll
            for (int j = 0; j < 8; ++j) t[j] = (f32x4){0.f, 0.f, 0.f, 0.f};
            for (int s0 = 0; s0 < nsplit; s0 += 4) {
                v2u wq[4][8];
#pragma unroll
                for (int u = 0; u < 4; ++u) if (s0 + u < nsplit) {
#pragma unroll
                    for (int j = 0; j < 8; ++j) wq[u][j] = __builtin_nontemporal_load((const v2u*)(TP + ((size_t)(s0 + u) * MS + (m - MP)) * DM + 4 * lane + 256 * j)); }
#pragma unroll
                for (int u = 0; u < 4; ++u) if (s0 + u < nsplit) {
#pragma unroll
                    for (int j = 0; j < 8; ++j) { const v2u w = wq[u][j]; t[j].x += blo(w.x); t[j].y += bhi(w.x); t[j].z += blo(w.y); t[j].w += bhi(w.y); } }
            }
        }
#pragma unroll
        for (int j = 0; j < 8; ++j) ts += (t[j].x * t[j].x + t[j].y * t[j].y) + (t[j].z * t[j].z + t[j].w * t[j].w);
        const float r = rsqrtf(wave_sum(ts) * (1.f / DM) + EPS);
        float ss = 0.f;
#pragma unroll
        for (int j = 0; j < 8; ++j) { const int idx = 4 * lane + 256 * j; const f32x4 x = __builtin_nontemporal_load((const f32x4*)(xr + idx)); const f32x4 gg = *(const f32x4*)(gpost + idx);
            t[j].x = x.x + t[j].x * r * gg.x; t[j].y = x.y + t[j].y * r * gg.y; t[j].z = x.z + t[j].z * r * gg.z; t[j].w = x.w + t[j].w * r * gg.w;
            __builtin_nontemporal_store(t[j], (f32x4*)(xo + idx)); ss += (t[j].x * t[j].x + t[j].y * t[j].y) + (t[j].z * t[j].z + t[j].w * t[j].w); }
        if (gnext) {
            const float r2 = rsqrtf(wave_sum(ss) * (1.f / DM) + EPS);
#pragma unroll
            for (int j = 0; j < 8; ++j) { const int idx = 4 * lane + 256 * j; const f32x4 gg = *(const f32x4*)(gnext + idx);
                v2u o; o.x = pk2(t[j].x * r2 * gg.x, t[j].y * r2 * gg.y); o.y = pk2(t[j].z * r2 * gg.z, t[j].w * r2 * gg.w); *(v2u*)(XB + (size_t)m * DM + idx) = o; }
        }
    }
}

constexpr int AT_KROW = 400, AT_VROW = 136, AT_VS = 64 * AT_KROW, AT_BUF = AT_VS + 128 * AT_VROW;
static_assert(AT_BUF % 16 == 0 && 2 * AT_BUF <= 131072, "attention LDS");
__device__ __forceinline__ void attn_unit(Ctx& C, int g, bool sample, int bsel, int hd, int qt) {
    int lane_ = C.lane; asm volatile("" : "+v"(lane_)); asm volatile("" : "+s"(C.ws), "+s"(C.out));
    const int w = C.wave, lane = lane_, tid = w * 64 + lane, r = lane & 31, hh = lane >> 5;
    LAS unsigned char* lds = C.lds;
    const bf16* QA = GPTR(GO_QA); const bf16* KN = GPTR(GO_KN); const bf16* KR = GPTR(GO_KR); const bf16* VT = GPTR(GO_VT); bf16* Y = GPTR(GO_Y);
    const int ldv = grp_ck(g);
    const int qrow0 = sample ? 8192 + bsel * 64 : bsel * 4096 + qt * 256;
    const int pos0 = sample ? PAST : qt * 256;
    const int ntiles = sample ? 17 : 4 * qt + 4;
    const bool wact = sample ? (w < 2) : true;
    const int jlim = sample ? 16 : 4 * qt + (w >> 1);
    bf16x8 qf[12];
#pragma unroll
    for (int s = 0; s < 12; ++s) qf[s] = (bf16x8){0, 0, 0, 0, 0, 0, 0, 0};
    if (wact) {
        const bf16* qp = QA + (size_t)(qrow0 + 32 * w + r) * 1536 + hd * 192 + 8 * hh;
#pragma unroll
        for (int s = 0; s < 8; ++s) qf[s] = *(const bf16x8*)(qp + 16 * s);
        const int pos = pos0 + 32 * w + r;
        const float* ca = (const float*)(C.ws + WS_ROPEA); const float* sa = ca + 4096 * 32;
#pragma unroll
        for (int sp = 0; sp < 2; ++sp) {
            const bf16x8 x1 = *(const bf16x8*)(qp + 128 + 16 * sp), x2 = *(const bf16x8*)(qp + 160 + 16 * sp);
            const float* ct = ca + pos * 32 + 16 * sp + 8 * hh; const float* st = sa + pos * 32 + 16 * sp + 8 * hh;
            float o1[8], o2[8];
#pragma unroll
            for (int j = 0; j < 8; ++j) { const float a = bf2f((unsigned short)x1[j]), b = bf2f((unsigned short)x2[j]), c = ct[j], s = st[j]; o1[j] = a * c - b * s; o2[j] = a * s + b * c; }
            qf[8 + sp] = pack8(o1[0], o1[1], o1[2], o1[3], o1[4], o1[5], o1[6], o1[7]);
            qf[10 + sp] = pack8(o2[0], o2[1], o2[2], o2[3], o2[4], o2[5], o2[6], o2[7]);
        }
    }
    f32x16 ot[4];
#pragma unroll
    for (int db = 0; db < 4; ++db)
#pragma unroll
        for (int i = 0; i < 16; ++i) ot[db][i] = 0.f;
    float mrun = -1e30f, lrun = 0.f;
    const float CS = 0.07216878364870322f * 1.4426950408889634f;
    v4u kreg[3], vreg[2];
#define AT_TROW(j) (sample ? ((j) < 16 ? 8192 + bsel * 1024 + 64 * (j) : 16384 + bsel * 64) : bsel * 4096 + 64 * (j))
#define AT_LOAD(j) do { const int trow_ = AT_TROW(j); \
        _Pragma("unroll") for (int i_ = 0; i_ < 3; ++i_) { const int c_ = tid + 512 * i_, key_ = c_ / 24, ch_ = c_ - 24 * key_; \
            kreg[i_] = ch_ < 16 ? *(const v4u*)((const char*)(KN + (size_t)trow_ * 1024 + hd * 128) + (unsigned)(key_ * 1024 + 8 * ch_) * 2u) : *(const v4u*)((const char*)(KR + (size_t)trow_ * 64) + (unsigned)(key_ * 64 + 8 * (ch_ - 16)) * 2u); } \
        _Pragma("unroll") for (int i_ = 0; i_ < 2; ++i_) { const int c_ = tid + 512 * i_, dv_ = c_ >> 3, ch_ = c_ & 7; \
            vreg[i_] = *(const v4u*)((const char*)(VT + (size_t)(hd * 128) * ldv + trow_) + (unsigned)(dv_ * ldv + 8 * ch_) * 2u); } } while (0)
#define AT_STORE(bufo) do { \
        _Pragma("unroll") for (int i_ = 0; i_ < 3; ++i_) { const int c_ = tid + 512 * i_, key_ = c_ / 24, ch_ = c_ - 24 * key_; *(LAS v4u*)(lds + (bufo) + key_ * AT_KROW + 16 * ch_) = kreg[i_]; } \
        _Pragma("unroll") for (int i_ = 0; i_ < 2; ++i_) { const int c_ = tid + 512 * i_, dv_ = c_ >> 3, ch_ = c_ & 7; \
            *(LAS v2u*)(lds + (bufo) + AT_VS + dv_ * AT_VROW + 16 * ch_) = (v2u){vreg[i_].x, vreg[i_].y}; *(LAS v2u*)(lds + (bufo) + AT_VS + dv_ * AT_VROW + 16 * ch_ + 8) = (v2u){vreg[i_].z, vreg[i_].w}; } } while (0)
    AT_LOAD(0);
    AT_STORE(0);
    __syncthreads();
    if (ntiles > 1) AT_LOAD(1);
    for (int j = 0; j < ntiles; ++j) {
        const int bo = (j & 1) * AT_BUF;
        if (wact && j <= jlim) {
            f32x16 s0, s1;
#pragma unroll
            for (int i = 0; i < 16; ++i) { s0[i] = 0.f; s1[i] = 0.f; }
#pragma unroll
            for (int s = 0; s < 12; ++s) {
                const bf16x8 a0 = *(const LAS bf16x8*)(lds + bo + r * AT_KROW + (16 * s + 8 * hh) * 2);
                const bf16x8 a1 = *(const LAS bf16x8*)(lds + bo + (32 + r) * AT_KROW + (16 * s + 8 * hh) * 2);
                s0 = MFMA32(a0, qf[s], s0); s1 = MFMA32(a1, qf[s], s1);
            }
            float mx = s0[0];
#pragma unroll
            for (int i = 0; i < 16; ++i) { mx = fmaxf(mx, s0[i]); mx = fmaxf(mx, s1[i]); }
            mx = fmaxf(mx, __shfl_xor(mx, 32));
            const float mnew = fmaxf(mrun, mx * CS);
            const float alpha = __builtin_amdgcn_exp2f(mrun - mnew);
            mrun = mnew; lrun *= alpha;
            if (__builtin_amdgcn_ballot_w64(alpha != 1.0f) != 0ull) {
#pragma unroll
                for (int db = 0; db < 4; ++db) ot[db] = ot[db] * alpha;
            }
#pragma unroll
            for (int i = 0; i < 16; ++i) { s0[i] = __builtin_amdgcn_exp2f(s0[i] * CS - mnew); s1[i] = __builtin_amdgcn_exp2f(s1[i] * CS - mnew); lrun += s0[i] + s1[i]; }
#pragma unroll
            for (int sub = 0; sub < 2; ++sub)
#pragma unroll
                for (int sp = 0; sp < 2; ++sp) {
                    const bf16x8 pf = sub == 0 ? pack8(s0[8 * sp], s0[8 * sp + 1], s0[8 * sp + 2], s0[8 * sp + 3], s0[8 * sp + 4], s0[8 * sp + 5], s0[8 * sp + 6], s0[8 * sp + 7])
                                               : pack8(s1[8 * sp], s1[8 * sp + 1], s1[8 * sp + 2], s1[8 * sp + 3], s1[8 * sp + 4], s1[8 * sp + 5], s1[8 * sp + 6], s1[8 * sp + 7]);
#pragma unroll
                    for (int db = 0; db < 4; ++db) {
                        const s16x4 lo = *(const LAS s16x4*)(lds + bo + AT_VS + (32 * db + r) * AT_VROW + (32 * sub + 16 * sp + 4 * hh) * 2);
                        const s16x4 hi = *(const LAS s16x4*)(lds + bo + AT_VS + (32 * db + r) * AT_VROW + (32 * sub + 16 * sp + 8 + 4 * hh) * 2);
                        ot[db] = MFMA32(cat4(lo, hi), pf, ot[db]);
                    }
                }
        }
        if (j + 1 < ntiles) { AT_STORE(AT_BUF - bo); }
        __syncthreads();
        if (j + 2 < ntiles) AT_LOAD(j + 2);
    }
    if (wact) {
        const float l = lrun + __shfl_xor(lrun, 32); const float inv = 1.0f / l;
        bf16* yp = Y + (size_t)(grp_row0(g) + qrow0 + 32 * w + r) * YW + 1024 + hd * 128 + 4 * hh;
#pragma unroll
        for (int db = 0; db < 4; ++db)
#pragma unroll
            for (int q = 0; q < 4; ++q) { v2u o; o.x = pk2(ot[db][4 * q] * inv, ot[db][4 * q + 1] * inv); o.y = pk2(ot[db][4 * q + 2] * inv, ot[db][4 * q + 3] * inv); *(v2u*)(yp + 32 * db + 8 * q) = o; }
    }
    __syncthreads();
#undef AT_TROW
#undef AT_LOAD
#undef AT_STORE
}

constexpr int SC_QROW = 272, SC_VROW = 576, SC_KCROW = 320, SC_HROW = 528;
constexpr int SC_QS = 0, SC_KS = 17408, SC_VS = 34816, SC_KSC = SC_VS + 64 * SC_VROW, SC_HT = SC_KSC + 64 * SC_KCROW, SC_SM = SC_HT + 64 * SC_HROW;
constexpr int SM_A = SC_SM, SM_MX = SM_A + 256, SM_PS = SM_MX + 256, SM_EM = SM_PS + 256, SM_WS = SM_EM + 256, SM_NQ = SM_WS + 256, SM_NV = SM_NQ + 256, SM_SC = SM_NV + 512, SM_RDW = SM_SC + 64;
static_assert(SM_RDW + 2048 <= 131072 && SC_SM % 16 == 0, "scan LDS");
#ifndef PROBE_SKIP
#define PROBE_SKIP 0
#endif
template <bool RET, bool sample, bool DRY = false>
__device__ __forceinline__ void scan_unit(Ctx& C, int layer, int bsel, int hd, const unsigned* ready = nullptr, unsigned need = 0u) {
    constexpr int SKIP = DRY ? PROBE_SKIP : 0;
    int w = C.wave; int lane = C.lane, tid = C.tid, r = lane & 31, hh = lane >> 5;
    int q4 = (lane & 15) >> 2, p4 = lane & 3, blk = (lane >> 4) & 1;
#define SC_LAUNDER() do { asm volatile("" : "+v"(lane)); asm volatile("" : "+s"(w)); tid = w * 64 + lane; r = lane & 31; hh = lane >> 5; q4 = (lane & 15) >> 2; p4 = lane & 3; blk = (lane >> 4) & 1; } while (0)
    SC_LAUNDER(); asm volatile("" : "+s"(C.ws), "+s"(C.out));
    LAS unsigned char* lds = C.lds;
    LAS float* A_ = (LAS float*)(lds + SM_A); LAS float* MX_ = (LAS float*)(lds + SM_MX); LAS float* PS_ = (LAS float*)(lds + SM_PS); LAS float* EM_ = (LAS float*)(lds + SM_EM);
    LAS float* WS_ = (LAS float*)(lds + SM_WS); LAS float* NQ_ = (LAS float*)(lds + SM_NQ); LAS float* NV_ = (LAS float*)(lds + SM_NV); LAS float* SC_ = (LAS float*)(lds + SM_SC);
    LAS float* RDW_ = (LAS float*)(lds + SM_RDW) + 64 * w;
    const bf16* Z = GPTR(GO_ZS); bf16* Y = GPTR(GO_Y);
    const int v0 = 32 * w;
    const int bglob = bsel;
    const int nch = sample ? 1 : 64;
    const size_t sidx = (size_t)(layer * 8 + bglob) * 4 + hd;
    const float KSCALE = 0.08838834764831845f;
    f32x16 Cacc[4];
#pragma unroll
    for (int db = 0; db < 4; ++db)
#pragma unroll
        for (int i = 0; i < 16; ++i) Cacc[db][i] = 0.f;
    if (sample) {
        if (!RET) {
            const float* c0 = cin(C, 4) + sidx * 256 * 128 + (size_t)(v0 + r) * 128;
#pragma unroll
            for (int db = 0; db < 4; ++db)
#pragma unroll
                for (int q = 0; q < 4; ++q) { const f32x4 t = *(const f32x4*)(c0 + 32 * db + 8 * q + 4 * hh); Cacc[db][4 * q] = t.x; Cacc[db][4 * q + 1] = t.y; Cacc[db][4 * q + 2] = t.z; Cacc[db][4 * q + 3] = t.w; }
        } else {
            const float* r0p = cin(C, 7) + sidx * 128 * 256 + v0 + r;
#pragma unroll
            for (int db = 0; db < 4; ++db)
#pragma unroll
                for (int i = 0; i < 16; ++i) Cacc[db][i] = r0p[(size_t)(32 * db + crow(i, hh)) * 256];
        }
    }
    if (!RET) {
        if (tid < 128) NV_[tid] = sample ? cin(C, 5)[sidx * 128 + tid] : 0.f;
        if (tid == 0) SC_[0] = sample ? cin(C, 6)[sidx] : 0.f;
    } else if (w == 0) {
        const float lg = log1pf(-exp2f(-5.0f - (float)hd));
        A_[lane] = -(float)lane * lg * 1.4426950408889634f; MX_[lane] = -(float)lane * lg * 1.4426950408889634f; PS_[lane] = expf((float)(lane + 1) * lg); WS_[lane] = expf((float)(63 - lane) * lg);
        if (lane == 0) SC_[1] = expf(64.0f * lg);
    }
    const float* cr = (const float*)(C.ws + WS_ROPER); const float* sr = cr + 4096 * 64;
    v4u pq[2], pk[2], pv[4]; float pig = 0.f, pfg = 0.f;
#define SC_ZROW(cn) (sample ? MP + bsel * 64 : bsel * 4096 + 64 * (cn))
#define SC_LOAD(cn) do { const char* Zn_ = (const char*)(Z + (size_t)SC_ZROW(cn) * ZSW); \
        if (!RET) { \
            _Pragma("unroll") for (int i_ = 0; i_ < 2; ++i_) { const int cc_ = tid + 512 * i_, row_ = cc_ >> 4, ch_ = cc_ & 15; const unsigned zo_ = (unsigned)(row_ * ZSW + hd * 128 + 8 * ch_) * 2u; \
                pq[i_] = *(const v4u*)(Zn_ + zo_ + ZS_MQ * 2); pk[i_] = *(const v4u*)(Zn_ + zo_ + ZS_MK * 2); } \
            if (w == 0) { const bf16* zr_ = (const bf16*)(Zn_ + (unsigned)(lane * ZSW + ZS_MISC + hd) * 2u); pig = bf2f(zr_[0]); pfg = bf2f(zr_[4]); } \
        } else { \
            const int row_ = tid >> 3, ch_ = tid & 7; const unsigned zo_ = (unsigned)(row_ * ZSW + hd * 128 + 8 * ch_) * 2u; \
            pq[0] = *(const v4u*)(Zn_ + zo_ + ZS_RQ * 2); pq[1] = *(const v4u*)(Zn_ + zo_ + ZS_RQ * 2 + 128); pk[0] = *(const v4u*)(Zn_ + zo_ + ZS_RK * 2); pk[1] = *(const v4u*)(Zn_ + zo_ + ZS_RK * 2 + 128); \
        } \
        _Pragma("unroll") for (int i_ = 0; i_ < 4; ++i_) { const int cc_ = tid + 512 * i_, row_ = cc_ >> 5, ch_ = cc_ & 31; \
            pv[i_] = *(const v4u*)(Zn_ + (unsigned)(row_ * ZSW + (RET ? ZS_RV : ZS_MV) + hd * 256 + 8 * ch_) * 2u); } } while (0)
#define SC_POLL(cn) do { if (ready && w == 0) { const unsigned* rp_ = ready + 16 * (SC_ZROW(cn) >> 8); unsigned sp_ = 0u; \
            while (__hip_atomic_load(rp_, __ATOMIC_RELAXED, __HIP_MEMORY_SCOPE_AGENT) < need) { __builtin_amdgcn_s_sleep(2); if (++sp_ > (1u << 17)) break; } \
            __builtin_amdgcn_fence(__ATOMIC_ACQUIRE, "agent"); asm volatile("s_waitcnt vmcnt(0)" ::: "memory"); } } while (0)
    SC_POLL(0);
    __syncthreads();
    SC_LOAD(0);
    for (int c = 0; c < nch; ++c) {
        const int zrow0 = SC_ZROW(c);
        SC_LAUNDER();
        const char* Zc = (const char*)(Z + (size_t)zrow0 * ZSW); char* Yc = (char*)(Y + (size_t)zrow0 * YW);
        if (!RET) {
#pragma unroll
            for (int i = 0; i < 2; ++i) { const int cc = tid + 512 * i, row = cc >> 4, ch = cc & 15;
                *(LAS v4u*)(lds + SC_QS + row * SC_QROW + 16 * ch) = pq[i]; *(LAS v4u*)(lds + SC_KS + row * SC_QROW + 16 * ch) = pk[i]; }
        } else {
            const int row = tid >> 3, ch = tid & 7;
            const unsigned to = (unsigned)(((sample ? PAST : 64 * c) + row) * 64 + 8 * ch) * 4u;
            f32x4 pcs[2], psn[2];
            pcs[0] = *(const f32x4*)((const char*)cr + to); pcs[1] = *(const f32x4*)((const char*)cr + to + 16); psn[0] = *(const f32x4*)((const char*)sr + to); psn[1] = *(const f32x4*)((const char*)sr + to + 16);
            const float cs[8] = {pcs[0].x, pcs[0].y, pcs[0].z, pcs[0].w, pcs[1].x, pcs[1].y, pcs[1].z, pcs[1].w}, sn[8] = {psn[0].x, psn[0].y, psn[0].z, psn[0].w, psn[1].x, psn[1].y, psn[1].z, psn[1].w};
#pragma unroll
            for (int which = 0; which < 2; ++which) {
                const v4u a = which ? pk[0] : pq[0], b = which ? pk[1] : pq[1];
                const float x1[8] = {blo(a.x), bhi(a.x), blo(a.y), bhi(a.y), blo(a.z), bhi(a.z), blo(a.w), bhi(a.w)}, x2[8] = {blo(b.x), bhi(b.x), blo(b.y), bhi(b.y), blo(b.z), bhi(b.z), blo(b.w), bhi(b.w)};
                const float sc = which ? KSCALE : 1.0f; float o1[8], o2[8];
#pragma unroll
                for (int j = 0; j < 8; ++j) { o1[j] = (x1[j] * cs[j] - x2[j] * sn[j]) * sc; o2[j] = (x1[j] * sn[j] + x2[j] * cs[j]) * sc; }
                v4u w1, w2; w1.x = pk2(o1[0], o1[1]); w1.y = pk2(o1[2], o1[3]); w1.z = pk2(o1[4], o1[5]); w1.w = pk2(o1[6], o1[7]); w2.x = pk2(o2[0], o2[1]); w2.y = pk2(o2[2], o2[3]); w2.z = pk2(o2[4], o2[5]); w2.w = pk2(o2[6], o2[7]);
                const int base = which ? SC_KS : SC_QS;
                *(LAS v4u*)(lds + base + row * SC_QROW + 16 * ch) = w1; *(LAS v4u*)(lds + base + row * SC_QROW + 16 * (ch + 8)) = w2;
            }
        }
#pragma unroll
        for (int i = 0; i < 4; ++i) { const int cc = tid + 512 * i, row = cc >> 5, ch = cc & 31; *(LAS v4u*)(lds + SC_VS + row * SC_VROW + 16 * ch) = pv[i]; }
        const float ig_c = pig, f_c = pfg;
        __syncthreads();
        if (!RET && !(SKIP & 1)) {
            if (w == 0) {
                const float ig = ig_c, f = f_c;
                const float lf = fminf(f, 0.f) - log1pf(expf(-fabsf(f)));
                float b = lf;
                b += dppk<0x111>(0.f, b); b += dppk<0x112>(0.f, b); b += dppk<0x114>(0.f, b); b += dppk<0x118>(0.f, b);
                { const float r1 = rdlane(b, 15), r2 = rdlane(b, 31), r3 = rdlane(b, 47); const int row = lane >> 4;
                  b += (row >= 1 ? r1 : 0.f) + (row >= 2 ? r2 : 0.f) + (row >= 3 ? r3 : 0.f); }
                const float a = ig - b; float am = a;
                am = fmaxf(am, dppk<0x111>(-3.0e38f, am)); am = fmaxf(am, dppk<0x112>(-3.0e38f, am)); am = fmaxf(am, dppk<0x114>(-3.0e38f, am)); am = fmaxf(am, dppk<0x118>(-3.0e38f, am));
                { const float r1 = rdlane(am, 15), r2 = rdlane(am, 31), r3 = rdlane(am, 47); const int row = lane >> 4;
                  am = fmaxf(am, fmaxf(row >= 1 ? r1 : -3.0e38f, fmaxf(row >= 2 ? r2 : -3.0e38f, row >= 3 ? r3 : -3.0e38f))); }
                const float mst = SC_[0];
                const float Mx = fmaxf(mst, am);
                A_[lane] = a * 1.4426950408889634f; MX_[lane] = Mx * 1.4426950408889634f + 3.5f; PS_[lane] = expf(mst - Mx); EM_[lane] = expf(-b - Mx);
                const float M63 = rdlane(Mx, 63), b63 = rdlane(b, 63);
                WS_[lane] = expf(a - M63);
                if (lane == 0) { SC_[1] = expf(mst - M63); SC_[0] = b63 + M63; }
            } else if (w == 1) {
                float acc = 0.f;
#pragma unroll
                for (int ch = 0; ch < 16; ++ch) { const v4u qv = *(const LAS v4u*)(lds + SC_QS + lane * SC_QROW + 16 * ch); const LAS float* nv = NV_ + 8 * ch;
                    acc += blo(qv.x) * nv[0] + bhi(qv.x) * nv[1] + blo(qv.y) * nv[2] + bhi(qv.y) * nv[3] + blo(qv.z) * nv[4] + bhi(qv.z) * nv[5] + blo(qv.w) * nv[6] + bhi(qv.w) * nv[7]; }
                NQ_[lane] = acc;
            }
        }
        __syncthreads();
        SC_LAUNDER();
        if (!(SKIP & 32))
#pragma unroll 1
        for (int i = 0; i < 2; ++i) { const int cc = tid + 512 * i, row = cc >> 4, ch = cc & 15; const v4u kv = *(const LAS v4u*)(lds + SC_KS + row * SC_QROW + 16 * ch);
            const float f = WS_[row] * (RET ? 1.0f : KSCALE);
            v4u o; o.x = pk2(blo(kv.x) * f, bhi(kv.x) * f); o.y = pk2(blo(kv.y) * f, bhi(kv.y) * f); o.z = pk2(blo(kv.z) * f, bhi(kv.z) * f); o.w = pk2(blo(kv.w) * f, bhi(kv.w) * f);
            *(LAS v4u*)(lds + SC_KSC + row * SC_KCROW + 16 * ch) = o; }
        f32x16 Zl[2];
#pragma unroll
        for (int lb = 0; lb < 2; ++lb)
#pragma unroll
            for (int i = 0; i < 16; ++i) Zl[lb][i] = 0.f;
        __builtin_amdgcn_sched_barrier(0);
        if (!(SKIP & 2))
#pragma unroll
        for (int db = 0; db < 4; ++db) {
            const bf16x8 cfa = pack8(Cacc[db][0], Cacc[db][1], Cacc[db][2], Cacc[db][3], Cacc[db][4], Cacc[db][5], Cacc[db][6], Cacc[db][7]);
            const bf16x8 cfb = pack8(Cacc[db][8], Cacc[db][9], Cacc[db][10], Cacc[db][11], Cacc[db][12], Cacc[db][13], Cacc[db][14], Cacc[db][15]);
#pragma unroll
            for (int lb = 0; lb < 2; ++lb) {
                const LAS unsigned char* qb_ = lds + SC_QS + (32 * lb + r) * SC_QROW + (32 * db + 4 * hh) * 2;
                const s16x4 lo0 = *(const LAS s16x4*)(qb_), hi0 = *(const LAS s16x4*)(qb_ + 16), lo1 = *(const LAS s16x4*)(qb_ + 32), hi1 = *(const LAS s16x4*)(qb_ + 48);
                Zl[lb] = MFMA32(cat4(lo0, hi0), cfa, Zl[lb]);
                Zl[lb] = MFMA32(cat4(lo1, hi1), cfb, Zl[lb]);
            }
        }
#pragma unroll
        for (int lb = 0; lb < 2; ++lb)
#pragma unroll
            for (int q = 0; q < 4; ++q) { const f32x4 pv4 = *(const LAS f32x4*)(PS_ + 32 * lb + 8 * q + 4 * hh); Zl[lb][4 * q] *= pv4.x; Zl[lb][4 * q + 1] *= pv4.y; Zl[lb][4 * q + 2] *= pv4.z; Zl[lb][4 * q + 3] *= pv4.w; }
        __builtin_amdgcn_sched_barrier(0);
        SC_LAUNDER();
        v2u zgr[8];
#pragma unroll
        for (int i = 0; i < 8; ++i) zgr[i] = *(const v2u*)(Zc + (unsigned)((8 * w + i) * ZSW + (RET ? ZS_RG : ZS_MO) + hd * 256 + 4 * lane) * 2u);
        float den[2] = {0.f, 0.f};
        if (!(SKIP & 4))
#pragma unroll
        for (int blkid = 0; blkid < 3; ++blkid) {
            const int sb = blkid == 2 ? 1 : 0, lb = blkid == 0 ? 0 : 1;
            f32x16 wt;
#pragma unroll
            for (int i = 0; i < 16; ++i) wt[i] = 0.f;
#pragma unroll
            for (int s = 0; s < 8; ++s) {
                const bf16x8 ka = *(const LAS bf16x8*)(lds + SC_KS + (32 * sb + r) * SC_QROW + (16 * s + 8 * hh) * 2);
                const bf16x8 qb = *(const LAS bf16x8*)(lds + SC_QS + (32 * lb + r) * SC_QROW + (16 * s + 8 * hh) * 2);
                wt = MFMA32(ka, qb, wt);
            }
            const int l = 32 * lb + r; const float Ml = MX_[l];
#pragma unroll
            for (int q = 0; q < 4; ++q) { const f32x4 av4 = *(const LAS f32x4*)(A_ + 32 * sb + 8 * q + 4 * hh); const float av[4] = {av4.x, av4.y, av4.z, av4.w};
#pragma unroll
                for (int k = 0; k < 4; ++k) { const int i = 4 * q + k; const int si = 32 * sb + crow(i, hh); const float e = __builtin_amdgcn_exp2f(av[k] - Ml); const float fct = (sb != lb || si <= l) ? e : 0.f; wt[i] *= fct; den[lb] += wt[i]; } }
#pragma unroll
            for (int sp = 0; sp < 2; ++sp) {
                const bf16x8 wf = pack8(wt[8 * sp], wt[8 * sp + 1], wt[8 * sp + 2], wt[8 * sp + 3], wt[8 * sp + 4], wt[8 * sp + 5], wt[8 * sp + 6], wt[8 * sp + 7]);
                const s16x4 lo = trrd(lds + SC_VS + (32 * sb + 16 * sp + 4 * hh + q4) * SC_VROW + (v0 + 16 * blk + 4 * p4) * 2);
                const s16x4 hi = trrd(lds + SC_VS + (32 * sb + 16 * sp + 8 + 4 * hh + q4) * SC_VROW + (v0 + 16 * blk + 4 * p4) * 2);
                Zl[lb] = MFMA32(wf, cat4(lo, hi), Zl[lb]);
            }
            __builtin_amdgcn_sched_barrier(0);
        }
        if (!RET) {
#pragma unroll
            for (int lb = 0; lb < 2; ++lb) { const int l = 32 * lb + r; const float d = den[lb] + __shfl_xor(den[lb], 32) + PS_[l] * NQ_[l];
                const float rd = 1.0f / fmaxf(fabsf(d), EM_[l]); if (hh == 0) RDW_[l] = rd; }
#pragma unroll
            for (int lb = 0; lb < 2; ++lb)
#pragma unroll
                for (int q = 0; q < 4; ++q) { const f32x4 rv4 = *(const LAS f32x4*)(RDW_ + 32 * lb + 8 * q + 4 * hh); Zl[lb][4 * q] *= rv4.x; Zl[lb][4 * q + 1] *= rv4.y; Zl[lb][4 * q + 2] *= rv4.z; Zl[lb][4 * q + 3] *= rv4.w; }
        }
#pragma unroll
        for (int lb = 0; lb < 2; ++lb)
#pragma unroll
            for (int i = 0; i < 16; ++i) *(LAS unsigned short*)(lds + SC_HT + (32 * lb + crow(i, hh)) * SC_HROW + (v0 + r) * 2) = (unsigned short)f2bf(Zl[lb][i]);
        if (c + 1 < nch && ((c + 1) & 3) == 0) SC_POLL(c + 1);
        __syncthreads();
        SC_LAUNDER();
        if (c + 1 < nch) SC_LOAD(c + 1);
        if (!(SKIP & 8))
        {
            const float carry = SC_[1];
#pragma unroll
            for (int db = 0; db < 4; ++db) Cacc[db] = Cacc[db] * carry;
            f32x16 nacc;
#pragma unroll
            for (int i = 0; i < 16; ++i) nacc[i] = 0.f;
            const bf16x8 ones = (bf16x8){0x3F80, 0x3F80, 0x3F80, 0x3F80, 0x3F80, 0x3F80, 0x3F80, 0x3F80};
#pragma unroll
            for (int sp = 0; sp < 4; ++sp) {
                const s16x4 vlo = trrd(lds + SC_VS + (16 * sp + 8 * hh + q4) * SC_VROW + (v0 + 16 * blk + 4 * p4) * 2);
                const s16x4 vhi = trrd(lds + SC_VS + (16 * sp + 8 * hh + 4 + q4) * SC_VROW + (v0 + 16 * blk + 4 * p4) * 2);
                const bf16x8 vb = cat4(vlo, vhi);
#pragma unroll
                for (int db = 0; db < 4; ++db) {
                    const s16x4 klo = trrd(lds + SC_KSC + (16 * sp + 8 * hh + q4) * SC_KCROW + (32 * db + 16 * blk + 4 * p4) * 2);
                    const s16x4 khi = trrd(lds + SC_KSC + (16 * sp + 8 * hh + 4 + q4) * SC_KCROW + (32 * db + 16 * blk + 4 * p4) * 2);
                    const bf16x8 ka = cat4(klo, khi);
                    Cacc[db] = MFMA32(ka, vb, Cacc[db]);
                    if (!RET && db == w) nacc = MFMA32(ka, ones, nacc);
                }
            }
            if (!RET && w < 4 && r == 0) {
#pragma unroll
                for (int i = 0; i < 16; ++i) { const int d = 32 * w + crow(i, hh); NV_[d] = carry * NV_[d] + nacc[i]; }
            }
        }
        __builtin_amdgcn_sched_barrier(0);
        SC_LAUNDER();
        if (!(SKIP & 16))
        {
            const float* gain = (RET ? cin(C, 18) : cin(C, 11)) + layer * 1024 + hd * 256 + 4 * lane;
            const f32x4 gg = *(const f32x4*)gain;
#pragma unroll
            for (int i = 0; i < 8; ++i) {
                const int l = 8 * w + i;
                const v2u hv = *(const LAS v2u*)(lds + SC_HT + l * SC_HROW + 8 * lane);
                float x0 = blo(hv.x), x1 = bhi(hv.x), x2 = blo(hv.y), x3 = bhi(hv.y);
                if (RET) { const float mean = wave_sum((x0 + x1) + (x2 + x3)) * (1.f / 256.f); x0 -= mean; x1 -= mean; x2 -= mean; x3 -= mean; }
                const float rs = rsqrtf(wave_sum((x0 * x0 + x1 * x1) + (x2 * x2 + x3 * x3)) * (1.f / 256.f) + EPS);
                const v2u zg = zgr[i];
                v2u o; o.x = pk2(x0 * rs * gg.x * blo(zg.x), x1 * rs * gg.y * bhi(zg.x)); o.y = pk2(x2 * rs * gg.z * blo(zg.y), x3 * rs * gg.w * bhi(zg.y));
                if (!DRY) *(v2u*)(Yc + (unsigned)(l * YW + (RET ? 2048 : 0) + hd * 256 + 4 * lane) * 2u) = o; else asm volatile("" :: "v"(o.x), "v"(o.y));
            }
        }
        __syncthreads();
    }
    SC_LAUNDER();
    if (!DRY)
    {
        float* ob = C.out;
        if (!RET) {
            float* co = ob + (sample ? O_SC : O_PC) + sidx * 256 * 128 + (size_t)(v0 + r) * 128;
#pragma unroll
            for (int db = 0; db < 4; ++db)
#pragma unroll
                for (int q = 0; q < 4; ++q) { const f32x4 t = {Cacc[db][4 * q], Cacc[db][4 * q + 1], Cacc[db][4 * q + 2], Cacc[db][4 * q + 3]}; *(f32x4*)(co + 32 * db + 8 * q + 4 * hh) = t; }
            if (tid < 128) ob[(sample ? O_SN : O_PN) + sidx * 128 + tid] = NV_[tid];
            if (tid == 0) ob[(sample ? O_SM : O_PM) + sidx] = SC_[0];
        } else {
            float* ro = ob + (sample ? O_SR : O_PR) + sidx * 128 * 256 + v0 + r;
#pragma unroll
            for (int db = 0; db < 4; ++db)
#pragma unroll
                for (int i = 0; i < 16; ++i) ro[(size_t)(32 * db + crow(i, hh)) * 256] = Cacc[db][i];
        }
    }
    __syncthreads();
#undef SC_LOAD
#undef SC_POLL
#undef SC_ZROW
#undef SC_LAUNDER
}

__device__ __forceinline__ void scan_phase(Ctx& C, int layer, int rep, const unsigned* ready) {
    volatile LAS unsigned* WQ = (volatile LAS unsigned*)(C.lds + MISC_OFF);
    unsigned* ctr = (unsigned*)(C.ws + WS_CTL) + 8 + layer + 16 * rep;
    for (;;) {
        { int t_ = C.lane; asm volatile("" : "+v"(t_)); if (C.wave == 0 && t_ == 0) WQ[0] = __hip_atomic_fetch_add(ctr, 1u, __ATOMIC_RELAXED, __HIP_MEMORY_SCOPE_AGENT); }
        __syncthreads();
        int it = (int)WQ[0];
        __syncthreads();
        if (it >= 64) break;
        if (it < 32) { scan_unit<false, true>(C, layer, it >> 2, it & 3, ready, 8u * (ZSW / 256)); continue; } it -= 32;
        scan_unit<true, true>(C, layer, it >> 2, it & 3, ready, 8u * (ZSW / 256));
    }
    if (layer == 0 && rep == 0) {
        unsigned* ctr2 = (unsigned*)(C.ws + WS_CTL) + 12;
        LAS float* scr = (LAS float*)(C.lds + C.wave * 16384);
        for (;;) {
            { int t_ = C.lane; asm volatile("" : "+v"(t_)); if (C.wave == 0 && t_ == 0) WQ[0] = __hip_atomic_fetch_add(ctr2, 1u, __ATOMIC_RELAXED, __HIP_MEMORY_SCOPE_AGENT); }
            __syncthreads();
            const int ch = (int)WQ[0];
            __syncthreads();
            constexpr int W_L0REST = W_NITEMS - W_I_IN - W_I_UQ - 2 * W_I_UK;
            if (ch * 64 >= W_L0REST + W_NITEMS) break;
#pragma unroll 1
            for (int j = 0; j < 8; ++j) { const int it2 = ch * 64 + j * 8 + C.wave;
                if (it2 < W_L0REST) weight_item(C, 0, W_I_IN + it2, scr); else if (it2 < W_L0REST + W_NITEMS) weight_item(C, 1, it2 - W_L0REST, scr); }
        }
    }
}
__device__ __forceinline__ void attn_phase(Ctx& C, int layer, int g, int rep) {
    volatile LAS unsigned* WQ = (volatile LAS unsigned*)(C.lds + MISC_OFF);
    unsigned* ctr = (unsigned*)(C.ws + WS_CTL) + (layer * 3 + g) + 16 * rep;
    const int nbg = g < 2 ? 3 : 2;
    const int n_pa = nbg * 8 * 16;
    const int n_sa = g == 2 ? 64 : 0;
    for (;;) {
        { int t_ = C.lane; asm volatile("" : "+v"(t_)); if (C.wave == 0 && t_ == 0) WQ[0] = __hip_atomic_fetch_add(ctr, 1u, __ATOMIC_RELAXED, __HIP_MEMORY_SCOPE_AGENT); }
        __syncthreads();
        int it = (int)WQ[0];
        __syncthreads();
        if (it >= n_pa + n_sa) break;
        if (it < n_pa) { int qt, rem; if (g < 2) { qt = 15 - it / 24; rem = it % 24; } else { qt = 15 - (it >> 4); rem = it & 15; } attn_unit(C, g, false, rem >> 3, rem & 7, qt); continue; } it -= n_pa;
        attn_unit(C, g, true, it >> 3, it & 7, 0);
    }
}

typedef GAS unsigned gu32;
#define XB_TMO      128
#define XB_XCNT(j)  (256  + 64 * (j))
#define XB_XSUB(j)  (1280 + 64 * (j))
#define XB_XGEN(j)  (2304 + 64 * (j))
#define XB_TOP      3328
#define XB_TOPGEN   3392
#define XCD_BAR_WORDS 3456
#define XB_SPIN_CAP (1u << 18)

__device__ __forceinline__ unsigned xb_ld(unsigned* p)              { return __hip_atomic_load(p, __ATOMIC_RELAXED, __HIP_MEMORY_SCOPE_AGENT); }
__device__ __forceinline__ unsigned xb_add(unsigned* p, unsigned v) { return __hip_atomic_fetch_add(p, v, __ATOMIC_RELAXED, __HIP_MEMORY_SCOPE_AGENT); }
__device__ __forceinline__ unsigned xb_xcc_id() { return (unsigned)__builtin_amdgcn_s_getreg((3 << 11) | 20) & 0xFu; }
#define XB_SPIN(cond, bar) do { unsigned _sp = 0; while (cond) { __builtin_amdgcn_s_sleep(1); \
    if ((++_sp & 255u) == 0u) { if (xb_ld(&(bar)[XB_TMO])) break; if (_sp > XB_SPIN_CAP) { atomicAdd(&(bar)[XB_TMO], 1u); break; } } } } while (0)

struct XcdBarrier {
    unsigned* bar; unsigned x;
    volatile LAS unsigned* st;
};

__device__ __forceinline__ XcdBarrier xcd_barrier_post(unsigned* bar, volatile LAS unsigned* st) {
    XcdBarrier b; b.bar = bar; b.x = xb_xcc_id(); b.st = st;
    if (threadIdx.x == 0) (void)xb_add(&bar[XB_XCNT(b.x)], 1u);
    return b;
}
__device__ __forceinline__ void xcd_barrier_complete(unsigned* bar, unsigned x, unsigned& nloc, unsigned& nx) {
    const unsigned G = gridDim.x * gridDim.y * gridDim.z;
    unsigned sum, cnt, mine, sp = 0u;
    for (;;) {
        sum = 0u; cnt = 0u; mine = 0u;
#pragma unroll
        for (unsigned j = 0; j < 16; ++j) { const unsigned c = xb_ld(&bar[XB_XCNT(j)]); sum += c; cnt += (c > 0u) ? 1u : 0u; mine = (j == x) ? c : mine; }
        if (sum == G) break;
        __builtin_amdgcn_s_sleep(1);
        if ((++sp & 255u) == 0u) { if (xb_ld(&bar[XB_TMO])) break; if (sp > XB_SPIN_CAP) { atomicAdd(&bar[XB_TMO], 1u); break; } }
    }
    nloc = mine > 0u ? mine : 1u; nx = cnt > 0u ? cnt : 1u;
}

__device__ __forceinline__ void xcd_barrier(const XcdBarrier& b) {
    asm volatile("s_waitcnt vmcnt(0)" ::: "memory");
    __syncthreads();
    if (threadIdx.x == 0) {
        unsigned* bar = b.bar;
        __builtin_amdgcn_s_waitcnt(0);
        unsigned nloc = b.st[0], nx = b.st[1];
        if (nloc == 0u) { xcd_barrier_complete(bar, b.x, nloc, nx); b.st[0] = nloc; b.st[1] = nx; }
        const unsigned old = xb_add(&bar[XB_XSUB(b.x)], 1u);
        const unsigned gen = old / nloc;
        if (old + 1u == (gen + 1u) * nloc) {
            __builtin_amdgcn_fence(__ATOMIC_RELEASE, "agent");
            asm volatile("s_waitcnt vmcnt(0)" ::: "memory");
            const unsigned og = xb_add(&bar[XB_TOP], 1u);
            const unsigned tg = og / nx;
            if (og + 1u == (tg + 1u) * nx) xb_add(&bar[XB_TOPGEN], 1u);
            else XB_SPIN(xb_ld(&bar[XB_TOPGEN]) == tg, bar);
            __builtin_amdgcn_fence(__ATOMIC_ACQUIRE, "agent");
            xb_add(&bar[XB_XGEN(b.x)], 1u);
            asm volatile("s_waitcnt vmcnt(0)" ::: "memory");
        } else {
            XB_SPIN(xb_ld(&bar[XB_XGEN(b.x)]) == gen, bar);
            __builtin_amdgcn_fence(__ATOMIC_ACQUIRE, "agent");
            asm volatile("s_waitcnt vmcnt(0)" ::: "memory");
        }
    }
    __syncthreads();
}

constexpr int CW_BAR = 4096;
#ifndef EN_MASK
#define EN_MASK 1023
#endif
constexpr int EN = EN_MASK;
__global__ void __launch_bounds__(NTHR, 2) mega_fwd(Args args) {
    extern __shared__ __attribute__((aligned(16))) unsigned char lds_raw[];
    cg::grid_group grid = cg::this_grid();
    Ctx C;
    C.lds = (LAS unsigned char*)lds_raw; C.tid = threadIdx.x; C.lane = C.tid & 63; C.wave = __builtin_amdgcn_readfirstlane(C.tid >> 6); C.G = gridDim.x; C.bid = blockIdx.x;
    if (C.tid == 0) {
#pragma unroll
        for (int i = 0; i < 26; ++i) *(LAS unsigned long long*)(C.lds + MISC_OFF + 64 + 8 * i) = (unsigned long long)args.in[i];
    }
    C.out = args.out; C.ws = args.ws;
    if (C.tid == 0) { ((volatile LAS unsigned*)(C.lds + MISC_OFF))[4] = 0u; ((volatile LAS unsigned*)(C.lds + MISC_OFF))[5] = 0u; }
    __syncthreads();
    XcdBarrier bar = xcd_barrier_post((unsigned*)(C.ws + WS_CTL) + CW_BAR, (volatile LAS unsigned*)(C.lds + MISC_OFF) + 4);
#define PHASE_BEGIN { asm volatile("" : "+s"(C.ws), "+s"(C.out)); asm volatile("" : "+s"(C.bid), "+s"(C.G));
#define PHASE_END(dosync) if (dosync) xcd_barrier(bar); }
#define PHASE_END_CG(dosync) if (dosync) grid.sync(); }
    LAS unsigned char* ring = C.lds;
    bf16* XB = (bf16*)(C.ws + WS_XB);

    PHASE_BEGIN if (EN & 1) p0_prologue(C); PHASE_END_CG(true)

    for (int layer = 0; layer < 2; ++layer) {
        PHASE_BEGIN {
            unsigned* ready = (unsigned*)(C.ws + WS_CTL) + 8192 + layer * 2080;
            if (C.bid < 64) {
                const int it = C.bid;
                if (it < 32) scan_unit<false, false>(C, layer, it >> 2, it & 3, ready, 8u * (ZSW / 256));
                else scan_unit<true, false>(C, layer, (it - 32) >> 2, it & 3, ready, 8u * (ZSW / 256));
            } else {
                pg8::Gemm gm{XB, WPTR(layer, WO_IN), MT, ZSW, DM}; pg8::ChunkOrder S; S.init(ZSW / 256, C.G - 64, C.bid - 64, ready);
                pg8::EpiBf16 E{GPTR(GO_ZS), ZSW, (const float*)(C.ws + WS_W + (size_t)layer * W_LAYER + WO_BIAS), 1 | 256, -1, -1};
                pg8::gemm_phase<pg8::EpiBf16, pg8::ChunkOrder, true, true>(ring, gm, S, E);
            }
            scan_phase(C, layer, 0, ready);
        } PHASE_END(true)
        for (int g = 0; g < 3; ++g) {
            const int rows = grp_rows(g), r0 = grp_row0(g), ckr = grp_ck(g);
            PHASE_BEGIN if (EN & 2) {
                pg8::Gemm gm{XB + (size_t)r0 * DM, WPTR(layer, WO_IN) + (size_t)ZSW * DM, rows, ZRW, DM}; pg8::StaticOrder S; S.init(rows, ZRW, C.G, C.bid);
                pg8::EpiBf16 E{GPTR(GO_Z), ZRW, (const float*)(C.ws + WS_W + (size_t)layer * W_LAYER + WO_BIAS) + ZSW, 2, -1, -1};
                pg8::gemm_phase<pg8::EpiBf16, pg8::StaticOrder, true, true>(ring, gm, S, E);
            } PHASE_END(true)
            PHASE_BEGIN if (EN & 4) pe_phase(C, layer, g); PHASE_END(true)
            PHASE_BEGIN if (EN & 8) {
                pg8::Gemm gm{GPTR(GO_QN), WPTR(layer, WO_UQ), 0, 0, 512, 512, 1 << 20, 0, GPTR(GO_CK), WPTR(layer, WO_UK), WPTR(layer, WO_V), GPTR(GO_CK)};
                pg8::TriOrder S; S.init(rows / 256, 6, ckr / 256, 4, 4, ckr / 256, C.G, C.bid);
                pg8::EpiBf16 E{GPTR(GO_QA), 1536, nullptr, 0, -1, -1, GPTR(GO_KN), 1024, GPTR(GO_VT), ckr};
                pg8::gemm_phase<pg8::EpiBf16, pg8::TriOrder, true, true>(ring, gm, S, E);
            } PHASE_END(true)
            PHASE_BEGIN if (EN & 16) attn_phase(C, layer, g, 0); PHASE_END(true)
            PHASE_BEGIN if (EN & 32) {
                pg8::Gemm gm{GPTR(GO_Y) + (size_t)r0 * YW, WPTR(layer, WO_UP), rows, DM, YW}; pg8::StaticOrder S; S.init(rows, DM, C.G, C.bid);
                pg8::EpiUp E{XB + (size_t)r0 * DM, DM, GPTR(GO_Z), 16, 32};
                pg8::gemm_phase<pg8::EpiUp, pg8::StaticOrder, true, true>(ring, gm, S, E);
            } PHASE_END(true)
        }
        PHASE_BEGIN if (EN & 64) {
            { pg8::Gemm gm{XB, WPTR(layer, WO_O), MP, DM, DM}; pg8::StaticOrder S; S.init(MP, DM, C.G, C.bid);
              pg8::EpiBf16 E{GPTR(GO_MIX), DM, nullptr, 0, -1, -1}; pg8::gemm_phase<pg8::EpiBf16, pg8::StaticOrder, true, true>(ring, gm, S, E); }
            { pg8::Gemm gm{XB + (size_t)MP * DM, WPTR(layer, WO_O), MS * 4, DM, 512, DM, 2, 512}; pg8::StaticOrder S; S.init(MS * 4, DM, C.G, C.bid);
              pg8::EpiBf16 E{GPTR(GO_TP), DM, nullptr, 0, -1, -1}; pg8::gemm_phase<pg8::EpiBf16, pg8::StaticOrder, true, true>(ring, gm, S, E); }
        } PHASE_END(true)
        PHASE_BEGIN if (EN & 128) px_phase(C, GPTR(GO_MIX), GPTR(GO_TP), 4, cin(C, 21) + layer * DM, cin(C, 22) + layer * DM, layer == 0); PHASE_END(true)
        PHASE_BEGIN if (EN & 256) {
            pg8::Gemm gm{XB, WPTR(layer, WO_GU), MT, 2 * DFF, DM}; pg8::StaticOrder S; S.init(MT, 2 * DFF, C.G, C.bid);
            pg8::EpiSwi E{GPTR(GO_ACT), DFF, -1, -1};
            pg8::gemm_phase<pg8::EpiSwi, pg8::StaticOrder, true, true>(ring, gm, S, E);
        } PHASE_END(true)
        PHASE_BEGIN if (EN & 512) {
            { pg8::Gemm gm{GPTR(GO_ACT), WPTR(layer, WO_DOWN), MP, DM, DFF}; pg8::StaticOrder S; S.init(MP, DM, C.G, C.bid);
              pg8::EpiBf16 E{GPTR(GO_MIX), DM, nullptr, 0, -1, -1}; pg8::gemm_phase<pg8::EpiBf16, pg8::StaticOrder, true, true>(ring, gm, S, E); }
            { pg8::Gemm gm{GPTR(GO_ACT) + (size_t)MP * DFF, WPTR(layer, WO_DOWN), MS * 11, DM, 512, DFF, 2, 512}; pg8::StaticOrder S; S.init(MS * 11, DM, C.G, C.bid);
              pg8::EpiBf16 E{GPTR(GO_TP), DM, nullptr, 0, -1, -1}; pg8::gemm_phase<pg8::EpiBf16, pg8::StaticOrder, true, true>(ring, gm, S, E); }
        } PHASE_END(true)
        PHASE_BEGIN if (EN & 128) px_phase(C, GPTR(GO_MIX), GPTR(GO_TP), 11, cin(C, 25) + layer * DM, layer == 0 ? cin(C, 8) + DM : nullptr, false); PHASE_END(true)
    }
#undef PHASE_BEGIN
#undef PHASE_END
#undef PHASE_END_CG
}

extern "C" void kernel_launch(void* const* d_in, const int* in_sizes, int n_in, void* d_out, int out_size, void* d_ws, size_t ws_size, hipStream_t stream) {
    static int grid = 0;
    if (grid == 0) {
        if (n_in != 26 || in_sizes[0] != MP * DM || (size_t)out_size != O_END || ws_size < WS_END) {
            fprintf(stderr, "kernel_launch: shape mismatch n_in %d in0 %d out %d ws %zu (need %zu)\n", n_in, n_in > 0 ? in_sizes[0] : -1, out_size, ws_size, (size_t)WS_END); grid = -1; return; }
        int dev = 0, cus = 0, per_cu = 0;
        hipGetDevice(&dev); hipDeviceGetAttribute(&cus, hipDeviceAttributeMultiprocessorCount, dev);
        hipFuncSetAttribute((const void*)mega_fwd, hipFuncAttributeMaxDynamicSharedMemorySize, LDS_BYTES);
        hipOccupancyMaxActiveBlocksPerMultiprocessor(&per_cu, (const void*)mega_fwd, NTHR, LDS_BYTES);
        (void)hipGetLastError();
        if (per_cu < 1) per_cu = 1;
        grid = cus * 1;
        if (grid <= 0) grid = 256;
    }
    if (grid < 0) return;
    if (hipMemsetAsync((char*)d_ws + WS_CTL, 0, 65536, stream) != hipSuccess) { fprintf(stderr, "memset failed\n"); return; }
    Args a{};
    for (int i = 0; i < 26; ++i) a.in[i] = (const float*)d_in[i];
    a.out = (float*)d_out; a.ws = (unsigned char*)d_ws; a.ph_lo = 0; a.ph_hi = 1000;
    void* kargs[] = {&a};
    hipError_t e = hipLaunchCooperativeKernel((const void*)mega_fwd, dim3(grid), dim3(NTHR), kargs, LDS_BYTES, stream);
    if (e != hipSuccess) fprintf(stderr, "cooperative launch failed: %s (grid %d)\n", hipGetErrorString(e), grid);
}
```

```cpp
#include <hip/hip_runtime.h>
#include <hip/hip_cooperative_groups.h>
#include <cstdio>
#include <cstdint>
namespace cg = cooperative_groups;
namespace pg8 {
#define PG8_LAS __attribute__((address_space(3)))
typedef unsigned short bf16_t;
typedef short bf16x8 __attribute__((ext_vector_type(8)));
typedef float f32x4 __attribute__((ext_vector_type(4)));
typedef unsigned u32x4 __attribute__((ext_vector_type(4)));
constexpr int BM = 256, BK = 64, HALF = 128, HTB = HALF * BK * 2  , STAGE_BYTES = 8 * HTB, NXCD = 8, WGM = 8;

__host__ __device__ __forceinline__ int lds_byte(int r, int c) { const int st = (r >> 4) * 2 + (c >> 5), rr = r & 15, cc = c & 31, ob = rr * 64 + cc * 2; return st * 1024 + (ob ^ (((ob >> 9) & 1) << 5)); }
__host__ __device__ __forceinline__ void stage_rc(int b, int& R, int& C) { const int st = b / 1024, sb = b % 1024, swz = sb ^ (((sb >> 9) & 1) << 5); R = (st >> 1) * 16 + swz / 64; C = (st & 1) * 32 + (swz % 64) / 2; }
__host__ __device__ __forceinline__ int perm32(int rho) { const int n = rho >> 4, i = rho & 15; return 8 * (i >> 2) + 4 * n + (i & 3); }

struct Unit { int pm, pn; int seg = 0; };
struct Gemm { const bf16_t* A; const bf16_t* Bt; int M, N, K; int ld = 0, nMr = 1 << 20, kslice = 0; const bf16_t* A1 = nullptr; const bf16_t* Bt1 = nullptr; const bf16_t* A2 = nullptr; const bf16_t* Bt2 = nullptr; };

struct StaticOrder {
    int nM, nN, nwg, G, c;
    __host__ __device__ void init(int M, int N, int G_, int c_) { nM = M / BM; nN = N / BM; nwg = nM * nN; G = G_; c = c_; }
    __host__ __device__ bool next(int i, Unit& u) const {
        const long L = (long)i * G + c; if (L >= nwg) return false;
        int wgid = (int)L; { const int q = nwg / NXCD, r = nwg % NXCD, xcd = wgid % NXCD, off = wgid / NXCD; wgid = (xcd < r ? xcd * (q + 1) : r * (q + 1) + (xcd - r) * q) + off; }
        const int nig = WGM * nN, gid = wgid / nig, fm = gid * WGM, gsz = (nM - fm) < WGM ? (nM - fm) : WGM;
        u.pm = fm + ((wgid % nig) % gsz); u.pn = (wgid % nig) / gsz; return true;
    }
    __device__ __forceinline__ void a_ready(const Unit&) const {}
    __device__ __forceinline__ void done(const Unit&) const {}
};


struct TriOrder {
    int n0, n1, n2, nN0, nN1, nN2, G, c;
    __host__ __device__ void init(int nM0_, int nN0_, int nM1_, int nN1_, int nM2_, int nN2_, int G_, int c_) { nN0 = nN0_; nN1 = nN1_; nN2 = nN2_; n0 = nM0_ * nN0_; n1 = nM1_ * nN1_; n2 = nM2_ * nN2_; G = G_; c = c_; }
    __host__ __device__ bool next(int i, Unit& u) const {
        int L = i * G + c; if (L >= n0 + n1 + n2) return false;
        if (L < n0) { u.seg = 0; u.pm = L / nN0; u.pn = L % nN0; return true; } L -= n0;
        if (L < n1) { u.seg = 1; u.pm = L / nN1; u.pn = L % nN1; return true; } L -= n1;
        u.seg = 2; u.pm = L / nN2; u.pn = L % nN2; return true;
    }
    __device__ __forceinline__ void a_ready(const Unit&) const {}
    __device__ __forceinline__ void done(const Unit&) const {}
};

struct ChunkOrder {
    int nN, G, c; unsigned* ready;
    __host__ __device__ void init(int nN_, int G_, int c_, unsigned* ready_) { nN = nN_; G = G_; c = c_; ready = ready_; }
    __host__ __device__ bool next(int i, Unit& u) const {
        int L = i * G + c; const int per = 8 * nN, nmain = 16 * per;
        if (L >= nmain + 2 * nN) return false;
        if (L < nmain) { const int t = L / per, idx = L % per; u.pm = (idx & 7) * 16 + t; u.pn = idx >> 3; return true; }
        L -= nmain; u.pm = 128 + (L & 1); u.pn = L >> 1; return true;
    }
    __device__ __forceinline__ void a_ready(const Unit&) const {}
    __device__ __forceinline__ void done(const Unit& u) const {
        asm volatile("s_waitcnt vmcnt(0)" ::: "memory");
        if ((threadIdx.x & 63) == 0) __hip_atomic_fetch_add(ready + 16 * u.pm, 1u, __ATOMIC_RELAXED, __HIP_MEMORY_SCOPE_AGENT);
    }
};
__device__ __forceinline__ unsigned cvt_pk_bf16(float lo, float hi) { unsigned r; asm volatile("v_cvt_pk_bf16_f32 %0, %1, %2" : "=v"(r) : "v"(lo), "v"(hi)); return r; }
__device__ __forceinline__ float bflo(unsigned w) { return __uint_as_float(w << 16); }
__device__ __forceinline__ float bfhi(unsigned w) { return __uint_as_float(w & 0xffff0000u); }
__device__ __forceinline__ float sigm(float v) { return __builtin_amdgcn_rcpf(1.0f + __expf(-v)); }
constexpr int ZSW = 6400, ZRW = 7424, ZW = ZSW + ZRW;
constexpr int ZS_MQ = 0, ZS_MK = 512, ZS_MV = 1024, ZS_MO = 2048, ZS_RQ = 3072, ZS_RK = 3584, ZS_RV = 4096, ZS_RG = 5120, ZS_MISC = 6144;
constexpr int ZR_DQ = 0, ZR_DKV = 512, ZR_KR = 1024, ZR_GM = 1280, ZR_GA = 3328, ZR_GR = 5376;

struct EpiBf16 {
    static constexpr bool PERM = true, AFTER_DRAIN = false, HOOK = false;
    bf16_t* O; int ldc; const float* bias; int actmode; int hook_t0, hook_t1; bf16_t* O1 = nullptr; int ldc1 = 0; bf16_t* O2 = nullptr; int ldc2 = 0;
    __device__ __forceinline__ void hook(f32x4 (&acc)[2][2][4][2], const Unit& u, int t, int wr, int wc, int fr, int fq) const {}
    __device__ __forceinline__ void operator()(const f32x4 (&acc)[2][2][4][2], const Unit& u, int wr, int wc, int fr, int fq) const {
        const bool wt = (actmode & 256) != 0; const int actmode_ = actmode & 255;
        int act = 0; { const int pn = u.pn; if (actmode_ == 1) act = (pn >= 8 && pn < 12) ? 1 : ((pn >= 20 && pn < 24) ? 2 : 0); else if (actmode_ == 2) act = pn >= 5 ? 1 : 0; }
        const int row0 = u.pm * BM + wr * 64 + fr; const int col0 = u.pn * BM + wc * 32 + 8 * fq;
        bf16_t* o0_ = O; bf16_t* o1_ = O1; bf16_t* o2_ = O2; int l0_ = ldc, l1_ = ldc1, l2_ = ldc2;
        asm volatile("" : "+s"(o0_), "+s"(o1_), "+s"(o2_), "+s"(l0_), "+s"(l1_), "+s"(l2_));
        bf16_t* Os = u.seg == 0 ? o0_ : (u.seg == 1 ? o1_ : o2_); const int lds_ = u.seg == 0 ? l0_ : (u.seg == 1 ? l1_ : l2_);
        f32x4 bv[2][2];
#pragma unroll
        for (int bj = 0; bj < 2; ++bj)
#pragma unroll
            for (int n = 0; n < 2; ++n) bv[bj][n] = bias ? *(const f32x4*)(bias + col0 + bj * HALF + 4 * n) : (f32x4){0.f, 0.f, 0.f, 0.f};
#pragma unroll
        for (int ai = 0; ai < 2; ++ai)
#pragma unroll
            for (int m = 0; m < 4; ++m) { bf16_t* rowp = Os + (size_t)(row0 + ai * HALF + m * 16) * lds_ + col0;
#pragma unroll
                for (int bj = 0; bj < 2; ++bj) { f32x4 v0 = acc[ai][bj][m][0] + bv[bj][0], v1 = acc[ai][bj][m][1] + bv[bj][1];
                    if (act == 1) {
#pragma unroll
                        for (int k = 0; k < 4; ++k) { v0[k] = sigm(v0[k]); v1[k] = sigm(v1[k]); }
                    } else if (act == 2) {
#pragma unroll
                        for (int k = 0; k < 4; ++k) { v0[k] = v0[k] * sigm(v0[k]); v1[k] = v1[k] * sigm(v1[k]); }
                    }
                    u32x4 w; w.x = cvt_pk_bf16(v0[0], v0[1]); w.y = cvt_pk_bf16(v0[2], v0[3]); w.z = cvt_pk_bf16(v1[0], v1[1]); w.w = cvt_pk_bf16(v1[2], v1[3]);
                    if (wt) asm volatile("global_store_dwordx4 %0, %1, off sc0 sc1" :: "v"(rowp + bj * HALF), "v"(w) : "memory");
                    else *(u32x4*)(rowp + bj * HALF) = w; } }
    }
};

struct EpiUp {
    static constexpr bool PERM = true, AFTER_DRAIN = false, HOOK = true;
    bf16_t* O; int ldc; const bf16_t* Zg; int hook_t0, hook_t1;
    __device__ __forceinline__ void hook(f32x4 (&acc)[2][2][4][2], const Unit& u, int t, int wr, int wc, int fr, int fq) const {
        const int cn = (t == hook_t0) ? ZR_GM : ZR_GA;
        int frl = fr, fql = fq; asm volatile("" : "+v"(frl), "+v"(fql));
        const char* zb = (const char*)(Zg + (size_t)(u.pm * BM + wr * 64) * ZRW + u.pn * BM + wc * 32 + cn);
        const unsigned lo = (unsigned)(frl * ZRW + 8 * fql) * 2u;
#pragma unroll
        for (int ai = 0; ai < 2; ++ai) {
            u32x4 gn[4][2], gd[4][2];
#pragma unroll
            for (int m = 0; m < 4; ++m) { const char* zr = zb + (lo + (unsigned)((ai * HALF + m * 16) * ZRW) * 2u);
#pragma unroll
                for (int bj = 0; bj < 2; ++bj) { gn[m][bj] = *(const u32x4*)(zr + bj * HALF * 2); gd[m][bj] = *(const u32x4*)(zr + 4096 + bj * HALF * 2); } }
#pragma unroll
            for (int m = 0; m < 4; ++m)
#pragma unroll
                for (int bj = 0; bj < 2; ++bj) { const u32x4 a = gn[m][bj], d = gd[m][bj];
                    f32x4 r0, r1;
                    r0[0] = bflo(a.x) * __builtin_amdgcn_rcpf(fmaxf(bflo(d.x), 1e-30f)); r0[1] = bfhi(a.x) * __builtin_amdgcn_rcpf(fmaxf(bfhi(d.x), 1e-30f));
                    r0[2] = bflo(a.y) * __builtin_amdgcn_rcpf(fmaxf(bflo(d.y), 1e-30f)); r0[3] = bfhi(a.y) * __builtin_amdgcn_rcpf(fmaxf(bfhi(d.y), 1e-30f));
                    r1[0] = bflo(a.z) * __builtin_amdgcn_rcpf(fmaxf(bflo(d.z), 1e-30f)); r1[1] = bfhi(a.z) * __builtin_amdgcn_rcpf(fmaxf(bfhi(d.z), 1e-30f));
                    r1[2] = bflo(a.w) * __builtin_amdgcn_rcpf(fmaxf(bflo(d.w), 1e-30f)); r1[3] = bfhi(a.w) * __builtin_amdgcn_rcpf(fmaxf(bfhi(d.w), 1e-30f));
                    acc[ai][bj][m][0] = acc[ai][bj][m][0] * r0; acc[ai][bj][m][1] = acc[ai][bj][m][1] * r1; }
            __builtin_amdgcn_sched_barrier(0);
        }
    }
    __device__ __forceinline__ void operator()(const f32x4 (&acc)[2][2][4][2], const Unit& u, int wr, int wc, int fr, int fq) const {
        const int row0 = u.pm * BM + wr * 64 + fr; const int col0 = u.pn * BM + wc * 32 + 8 * fq;
#pragma unroll
        for (int ai = 0; ai < 2; ++ai)
#pragma unroll
            for (int m = 0; m < 4; ++m) { const size_t rr = (size_t)(row0 + ai * HALF + m * 16); const bf16_t* zr = Zg + rr * ZRW + ZR_GR + col0; bf16_t* rowp = O + rr * ldc + col0;
#pragma unroll
                for (int bj = 0; bj < 2; ++bj) { const u32x4 g = *(const u32x4*)(zr + bj * HALF);
                    f32x4 v0 = acc[ai][bj][m][0], v1 = acc[ai][bj][m][1];
                    v0[0] *= bflo(g.x); v0[1] *= bfhi(g.x); v0[2] *= bflo(g.y); v0[3] *= bfhi(g.y);
                    v1[0] *= bflo(g.z); v1[1] *= bfhi(g.z); v1[2] *= bflo(g.w); v1[3] *= bfhi(g.w);
                    u32x4 w; w.x = cvt_pk_bf16(v0[0], v0[1]); w.y = cvt_pk_bf16(v0[2], v0[3]); w.z = cvt_pk_bf16(v1[0], v1[1]); w.w = cvt_pk_bf16(v1[2], v1[3]);
                    *(u32x4*)(rowp + bj * HALF) = w; }
                if (m == 3) __builtin_amdgcn_sched_barrier(0); }
    }
};

struct EpiStat {
    static constexpr bool PERM = true, AFTER_DRAIN = false, HOOK = false;
    bf16_t* O; int ldc; float* stats; int hook_t0, hook_t1;
    __device__ __forceinline__ void hook(f32x4 (&acc)[2][2][4][2], const Unit& u, int t, int wr, int wc, int fr, int fq) const {}
    __device__ __forceinline__ void operator()(const f32x4 (&acc)[2][2][4][2], const Unit& u, int wr, int wc, int fr, int fq) const {
        const int row0 = u.pm * BM + wr * 64 + fr; const int col0 = u.pn * BM + wc * 32 + 8 * fq;
#pragma unroll
        for (int ai = 0; ai < 2; ++ai)
#pragma unroll
            for (int m = 0; m < 4; ++m) { const size_t rr = (size_t)(row0 + ai * HALF + m * 16); bf16_t* rowp = O + rr * ldc + col0; float s = 0.f;
#pragma unroll
                for (int bj = 0; bj < 2; ++bj) { const f32x4 v0 = acc[ai][bj][m][0], v1 = acc[ai][bj][m][1];
                    s += (v0[0] * v0[0] + v0[1] * v0[1]) + (v0[2] * v0[2] + v0[3] * v0[3]) + (v1[0] * v1[0] + v1[1] * v1[1]) + (v1[2] * v1[2] + v1[3] * v1[3]);
                    u32x4 w; w.x = cvt_pk_bf16(v0[0], v0[1]); w.y = cvt_pk_bf16(v0[2], v0[3]); w.z = cvt_pk_bf16(v1[0], v1[1]); w.w = cvt_pk_bf16(v1[2], v1[3]);
                    *(u32x4*)(rowp + bj * HALF) = w; }
                s += __shfl_xor(s, 16); s += __shfl_xor(s, 32);
                if (fq == 0) stats[(rr * 8 + u.pn) * 4 + wc] = s; }
    }
};

struct EpiSwi {
    static constexpr bool PERM = true, AFTER_DRAIN = false, HOOK = false;
    bf16_t* O; int ldc; int hook_t0, hook_t1;
    __device__ __forceinline__ void hook(f32x4 (&acc)[2][2][4][2], const Unit& u, int t, int wr, int wc, int fr, int fq) const {}
    __device__ __forceinline__ void operator()(const f32x4 (&acc)[2][2][4][2], const Unit& u, int wr, int wc, int fr, int fq) const {
        const int row0 = u.pm * BM + wr * 64 + fr; const int col0 = u.pn * HALF + wc * 32 + 8 * fq;
#pragma unroll
        for (int ai = 0; ai < 2; ++ai)
#pragma unroll
            for (int m = 0; m < 4; ++m) { bf16_t* rowp = O + (size_t)(row0 + ai * HALF + m * 16) * ldc + col0;
                f32x4 a0 = acc[ai][0][m][0], a1 = acc[ai][0][m][1]; const f32x4 g0 = acc[ai][1][m][0], g1 = acc[ai][1][m][1];
#pragma unroll
                for (int k = 0; k < 4; ++k) { a0[k] = a0[k] * g0[k] * sigm(g0[k]); a1[k] = a1[k] * g1[k] * sigm(g1[k]); }
                u32x4 w; w.x = cvt_pk_bf16(a0[0], a0[1]); w.y = cvt_pk_bf16(a0[2], a0[3]); w.z = cvt_pk_bf16(a1[0], a1[1]); w.w = cvt_pk_bf16(a1[2], a1[3]);
                *(u32x4*)rowp = w; }
    }
};

template <class Epi, class Sched, bool ALIGN_EPI = false, bool SP2 = false>
__device__ __forceinline__ void gemm_phase(PG8_LAS unsigned char* lds, const Gemm g, const Sched& S, const Epi& E) {
    int tid_ = threadIdx.x; asm volatile("" : "+v"(tid_));
    const int tid = tid_, wid = __builtin_amdgcn_readfirstlane(tid >> 6), lane = tid & 63, wr = wid >> 2, wc = wid & 3, fr = lane & 15, fq = lane >> 4;
    const int K = g.K, nt = K / BK, LD = g.ld ? g.ld : K;
    unsigned voffA[2], voffB[2];
#pragma unroll
    for (int i = 0; i < 2; ++i) { int R, C; stage_rc(tid * 16 + i * 8192, R, C); const int Rb = Epi::PERM ? ((R & ~31) + perm32(R & 31)) : R;
        voffA[i] = (unsigned)(R * LD + C) * 2u; voffB[i] = (unsigned)(Rb * LD + C) * 2u; }
    const size_t kstep = (size_t)(BK * 2);
    const size_t hstep = (size_t)HALF * LD * 2;
    const size_t tstep = 2 * hstep;
    const unsigned ldsw = (unsigned)wid * 1024u;
    const int aoff = lds_byte(wr * 64 + fr, fq * 8), boff = lds_byte(wc * 32 + fr, fq * 8);
#define PG8_SA(b, h) (((b) * 2 + (h)) * HTB)
#define PG8_SB(b, h) ((4 + (b) * 2 + (h)) * HTB)
#define PG8_STAGE(bufoff, gbase, voff) do { _Pragma("unroll") for (int _i = 0; _i < 2; ++_i) \
        __builtin_amdgcn_global_load_lds((const unsigned*)((const char*)(gbase) + (voff)[_i]), (PG8_LAS unsigned*)(lds + (bufoff) + ldsw + _i * 8192), 16, 0, 0); } while (0)
#define PG8_LDA(dst, b, h) do { _Pragma("unroll") for (int m = 0; m < 4; ++m) _Pragma("unroll") for (int k = 0; k < 2; ++k) dst[m][k] = *(const PG8_LAS bf16x8*)(lds + PG8_SA(b, h) + aoff + m * 2048 + k * 1024); } while (0)
#define PG8_LDB(dst, b, h) do { _Pragma("unroll") for (int n = 0; n < 2; ++n) _Pragma("unroll") for (int k = 0; k < 2; ++k) dst[n][k] = *(const PG8_LAS bf16x8*)(lds + PG8_SB(b, h) + boff + n * 2048 + k * 1024); } while (0)
#define PG8_MMA(ai, bj, At, Bt) do { __builtin_amdgcn_s_setprio(1); _Pragma("unroll") for (int m = 0; m < 4; ++m) _Pragma("unroll") for (int n = 0; n < 2; ++n) _Pragma("unroll") for (int k = 0; k < 2; ++k) \
        acc[ai][bj][m][n] = __builtin_amdgcn_mfma_f32_16x16x32_bf16(Bt[n][k], At[m][k], acc[ai][bj][m][n], 0, 0, 0); __builtin_amdgcn_s_setprio(0); } while (0)
#define PG8_WAIT_V(n) asm volatile("s_waitcnt vmcnt(" #n ")" ::: "memory")
#define PG8_WAIT_L(n) asm volatile("s_waitcnt lgkmcnt(" #n ")" ::: "memory")
#define PG8_BAR __builtin_amdgcn_s_barrier()
#define PG8_SCHED __builtin_amdgcn_sched_barrier(0)
    Unit cur, nxt; int ui = 0;
    if (!S.next(0, cur)) return;
    f32x4 acc[2][2][4][2];
#pragma unroll
    for (int a = 0; a < 2; ++a)
#pragma unroll
        for (int b = 0; b < 2; ++b)
#pragma unroll
            for (int m = 0; m < 4; ++m)
#pragma unroll
                for (int n = 0; n < 2; ++n) acc[a][b][m][n] = (f32x4){0.f, 0.f, 0.f, 0.f};
    bf16x8 At[4][2], B0[2][2], B1[2][2];
    const char* const gA0_ = (const char*)g.A; const char* const gA1_ = (const char*)g.A1; const char* const gA2_ = (const char*)g.A2;
    const char* const gB0_ = (const char*)g.Bt; const char* const gB1_ = (const char*)g.Bt1; const char* const gB2_ = (const char*)g.Bt2;
    const int gnMr_ = g.nMr, gks_ = g.kslice;
    { const char* a0 = gA0_; (void)a0; }
#define PG8_ABASE(u) (((u).seg == 0 ? gA0_ : ((u).seg == 1 ? gA1_ : gA2_)) + (size_t)((u).pm % gnMr_) * tstep + (size_t)((u).pm / gnMr_) * gks_ * 2)
#define PG8_BBASE(u) (((u).seg == 0 ? gB0_ : ((u).seg == 1 ? gB1_ : gB2_)) + (size_t)(u).pn * tstep + (size_t)((u).pm / gnMr_) * gks_ * 2)
    const char* cA = PG8_ABASE(cur); const char* cB = PG8_BBASE(cur);
    S.a_ready(cur);
    if constexpr (SP2) {
        PG8_STAGE(PG8_SB(0, 0), cB, voffB); PG8_STAGE(PG8_SB(0, 1), cB + hstep, voffB); PG8_STAGE(PG8_SA(0, 0), cA, voffA); PG8_STAGE(PG8_SA(0, 1), cA + hstep, voffA);
        if (wr == 1) PG8_BAR;
        PG8_WAIT_V(2); PG8_BAR;
        PG8_STAGE(PG8_SB(1, 0), cB + kstep, voffB); PG8_STAGE(PG8_SA(1, 0), cA + kstep, voffA); PG8_STAGE(PG8_SB(1, 1), cB + hstep + kstep, voffB);
        PG8_WAIT_V(6); PG8_BAR;
    } else {
        PG8_STAGE(PG8_SB(0, 0), cB, voffB); PG8_STAGE(PG8_SA(0, 0), cA, voffA); PG8_STAGE(PG8_SB(0, 1), cB + hstep, voffB); PG8_STAGE(PG8_SA(0, 1), cA + hstep, voffA);
        if (wr == 1) PG8_BAR;
        PG8_WAIT_V(4); PG8_BAR;
        PG8_STAGE(PG8_SB(1, 0), cB + kstep, voffB); PG8_STAGE(PG8_SA(1, 0), cA + kstep, voffA); PG8_STAGE(PG8_SB(1, 1), cB + hstep + kstep, voffB);
        PG8_WAIT_V(6); PG8_BAR;
    }
    for (;;) {
        const bool has_next = S.next(ui + 1, nxt);
        const char* nA = has_next ? PG8_ABASE(nxt) : cA; const char* nB = has_next ? PG8_BBASE(nxt) : cB;
        for (int t = 0; t < nt; t += 2) {
            if constexpr (Epi::HOOK) { if (t == E.hook_t0 || t == E.hook_t1) E.hook(acc, cur, t, wr, wc, fr, fq); }
            const bool last = (t == nt - 2);
            const char* a1 = cA + (size_t)(t + 1) * kstep;
            const char* a2 = last ? nA : cA + (size_t)(t + 2) * kstep; const char* b2 = last ? nB : cB + (size_t)(t + 2) * kstep;
            const char* a3 = a2 + kstep; const char* b3 = b2 + kstep;
            if (last && has_next) S.a_ready(nxt);
            if constexpr (SP2) {
            PG8_LDB(B0, 0, 0); PG8_LDB(B1, 0, 1); PG8_SCHED; PG8_LDA(At, 0, 0); PG8_STAGE(PG8_SA(1, 1), a1 + hstep, voffA);
            PG8_WAIT_V(8); PG8_WAIT_L(0); PG8_BAR; PG8_MMA(0, 0, At, B0); PG8_MMA(0, 1, At, B1); PG8_BAR; PG8_SCHED;
            PG8_LDA(At, 0, 1); PG8_STAGE(PG8_SB(0, 0), b2, voffB); PG8_STAGE(PG8_SB(0, 1), b2 + hstep, voffB); PG8_STAGE(PG8_SA(0, 0), a2, voffA);
            PG8_WAIT_V(8); PG8_WAIT_L(0); PG8_BAR; PG8_MMA(1, 0, At, B0); PG8_MMA(1, 1, At, B1); PG8_BAR; PG8_SCHED;
            PG8_LDB(B0, 1, 0); PG8_LDB(B1, 1, 1); PG8_SCHED; PG8_LDA(At, 1, 0); PG8_STAGE(PG8_SA(0, 1), a2 + hstep, voffA);
            PG8_WAIT_V(8); PG8_WAIT_L(0); PG8_BAR; PG8_MMA(0, 0, At, B0); PG8_MMA(0, 1, At, B1); PG8_BAR; PG8_SCHED;
            PG8_LDA(At, 1, 1); PG8_STAGE(PG8_SB(1, 0), b3, voffB); PG8_STAGE(PG8_SB(1, 1), b3 + hstep, voffB); PG8_STAGE(PG8_SA(1, 0), a3, voffA);
            PG8_WAIT_V(8); PG8_WAIT_L(0); PG8_BAR; PG8_MMA(1, 0, At, B0); PG8_MMA(1, 1, At, B1); PG8_BAR; PG8_SCHED;
            } else {
            PG8_LDB(B0, 0, 0); PG8_SCHED; PG8_LDA(At, 0, 0); PG8_STAGE(PG8_SA(1, 1), a1 + hstep, voffA);
            PG8_WAIT_L(8); PG8_BAR; PG8_WAIT_L(0); PG8_MMA(0, 0, At, B0); PG8_BAR; PG8_SCHED;
            PG8_LDB(B1, 0, 1); PG8_STAGE(PG8_SB(0, 0), b2, voffB);
            PG8_BAR; PG8_WAIT_L(0); PG8_MMA(0, 1, At, B1); PG8_BAR;
            PG8_LDA(At, 0, 1); PG8_STAGE(PG8_SA(0, 0), a2, voffA);
            PG8_BAR; PG8_WAIT_L(0); PG8_MMA(1, 0, At, B0); PG8_BAR; PG8_SCHED;
            PG8_STAGE(PG8_SB(0, 1), b2 + hstep, voffB);
            PG8_WAIT_V(6); PG8_BAR; PG8_MMA(1, 1, At, B1); PG8_BAR;
            PG8_LDB(B0, 1, 0); PG8_SCHED; PG8_LDA(At, 1, 0); PG8_STAGE(PG8_SA(0, 1), a2 + hstep, voffA);
            PG8_WAIT_L(8); PG8_BAR; PG8_WAIT_L(0); PG8_MMA(0, 0, At, B0); PG8_BAR; PG8_SCHED;
            PG8_LDB(B1, 1, 1); PG8_STAGE(PG8_SB(1, 0), b3, voffB);
            PG8_BAR; PG8_WAIT_L(0); PG8_MMA(0, 1, At, B1); PG8_BAR;
            PG8_LDA(At, 1, 1); PG8_STAGE(PG8_SA(1, 0), a3, voffA);
            PG8_BAR; PG8_WAIT_L(0); PG8_MMA(1, 0, At, B0); PG8_BAR; PG8_SCHED;
            PG8_STAGE(PG8_SB(1, 1), b3 + hstep, voffB);
            PG8_WAIT_V(6); PG8_BAR; PG8_MMA(1, 1, At, B1); PG8_BAR;
            }
        }
        if constexpr (ALIGN_EPI) { if (wr == 0) PG8_BAR; }
        if constexpr (!Epi::AFTER_DRAIN) { E(acc, cur, wr, wc, fr, fq); S.done(cur); }
        if (!has_next) break;
#pragma unroll
        for (int a = 0; a < 2; ++a)
#pragma unroll
            for (int b = 0; b < 2; ++b)
#pragma unroll
                for (int m = 0; m < 4; ++m)
#pragma unroll
                    for (int n = 0; n < 2; ++n) acc[a][b][m][n] = (f32x4){0.f, 0.f, 0.f, 0.f};
        cur = nxt; cA = nA; cB = nB; ++ui;
        if constexpr (ALIGN_EPI) { if (wr == 1) PG8_BAR; }
    }
    PG8_WAIT_V(0);
    if constexpr (!ALIGN_EPI) { if (wr == 0) PG8_BAR; }
    PG8_BAR;
    if constexpr (Epi::AFTER_DRAIN) { E.fused(acc, cur, wr, wc, fr, fq, lds, wid, lane); S.done(cur); }
#undef PG8_ABASE
#undef PG8_BBASE
#undef PG8_SA
#undef PG8_SB
#undef PG8_STAGE
#undef PG8_LDA
#undef PG8_LDB
#undef PG8_MMA
#undef PG8_WAIT_V
#undef PG8_WAIT_L
#undef PG8_BAR
#undef PG8_SCHED
}
}

#define GAS __attribute__((address_space(1)))
#define LAS __attribute__((address_space(3)))
typedef unsigned short bf16;
typedef unsigned v4u __attribute__((ext_vector_type(4)));
typedef unsigned v2u __attribute__((ext_vector_type(2)));
typedef float f32x4 __attribute__((ext_vector_type(4)));
typedef float f32x16 __attribute__((ext_vector_type(16)));
typedef short bf16x8 __attribute__((ext_vector_type(8)));
typedef short s16x4 __attribute__((ext_vector_type(4)));
typedef short v4i16_t __attribute__((ext_vector_type(4)));
#define MFMA32(a, b, c) __builtin_amdgcn_mfma_f32_32x32x16_bf16((a), (b), (c), 0, 0, 0)
using pg8::ZSW; using pg8::ZRW; using pg8::ZW; using pg8::ZS_MQ; using pg8::ZS_MK; using pg8::ZS_MV; using pg8::ZS_MO; using pg8::ZS_RQ; using pg8::ZS_RK; using pg8::ZS_RV; using pg8::ZS_RG; using pg8::ZS_MISC; using pg8::ZR_DQ; using pg8::ZR_DKV; using pg8::ZR_KR; using pg8::ZR_GM; using pg8::ZR_GA; using pg8::ZR_GR;

constexpr int NWAVES = 8, NTHR = 512;
constexpr int DM = 2048, NBATCH = 8, SEQ = 4096, DSEQ = 64, PAST = 1024, DFF = 5632, DIN = 13384;
constexpr int MP = NBATCH * SEQ, MS = NBATCH * DSEQ, MT = MP + MS;
constexpr float EPS = 1e-6f;
constexpr int YW = 3072;
__device__ __forceinline__ int grp_row0(int g) { return g * 12288; }
__device__ __forceinline__ int grp_rows(int g) { return g < 2 ? 12288 : 8704; }
__device__ __forceinline__ int grp_ck(int g) { return g < 2 ? 12288 : 16896; }
constexpr int GROWS_MAX = 12288, GCK_MAX = 16896;

constexpr size_t MiB = 1u << 20;
constexpr size_t WS_CTL = 0;
constexpr size_t WS_ROPEA = 1 * MiB;
constexpr size_t WS_ROPER = 2 * MiB;
constexpr size_t WS_W = 4 * MiB, W_LAYER = 144 * MiB;
constexpr size_t WO_IN = 0, WO_GU = WO_IN + (size_t)ZW * DM * 2, WO_DOWN = WO_GU + (size_t)2 * DFF * DM * 2, WO_O = WO_DOWN + (size_t)DM * DFF * 2,
                 WO_UP = WO_O + (size_t)DM * DM * 2, WO_UQ = WO_UP + (size_t)DM * YW * 2, WO_UK = WO_UQ + (size_t)1536 * 512 * 2, WO_V = WO_UK + (size_t)1024 * 512 * 2,
                 WO_BIAS = WO_V + (size_t)1024 * 512 * 2, WO_END = WO_BIAS + (size_t)ZW * 4;
static_assert(WO_END <= W_LAYER, "weights per layer");
constexpr size_t WS_XB = WS_W + 2 * W_LAYER;
constexpr size_t WS_G = WS_XB + (size_t)MT * DM * 2;
constexpr size_t GO_ZS = 0, GO_ZS_END = (size_t)MT * ZSW * 2;
constexpr size_t GO_Z = 0, GO_QA = GO_Z + (size_t)GROWS_MAX * ZRW * 2, GO_QN = GO_QA + (size_t)GROWS_MAX * 1536 * 2, GO_CK = GO_QN + (size_t)GROWS_MAX * 512 * 2,
                 GO_KR = GO_CK + (size_t)GCK_MAX * 512 * 2, GO_KN = GO_KR + (size_t)GCK_MAX * 64 * 2, GO_VT = GO_KN + (size_t)GCK_MAX * 1024 * 2, GO_GEND = GO_VT + (size_t)GCK_MAX * 1024 * 2;
static_assert(GO_GEND <= GO_ZS_END, "group buffers overlay Zs");
constexpr size_t GO_Y = GO_ZS_END, GO_END = GO_Y + (size_t)MT * YW * 2;
constexpr size_t GO_ACT = 0, GO_MIX = (size_t)MT * DFF * 2, GO_TP = GO_MIX + (size_t)MT * DM * 2;
static_assert(GO_TP + (size_t)11 * MS * DM * 2 <= GO_END, "overlay");
constexpr size_t WS_END = WS_G + GO_END;
static_assert(WS_END <= (size_t)1024 * MiB, "ws");

constexpr int LDS_BYTES = 147456;
constexpr int MISC_OFF = 131072;

__device__ __forceinline__ float bf2f(unsigned short b) { return __uint_as_float((unsigned)b << 16); }
typedef __bf16 hwbf2 __attribute__((ext_vector_type(2)));
typedef float hwf2 __attribute__((ext_vector_type(2)));
__device__ __forceinline__ unsigned pk2(float lo, float hi) { hwf2 v = {lo, hi}; return __builtin_bit_cast(unsigned, __builtin_convertvector(v, hwbf2)); }
__device__ __forceinline__ unsigned f2bf(float f) { return pk2(f, 0.f) & 0xffffu; }
__device__ __forceinline__ float blo(unsigned w) { return __uint_as_float(w << 16); }
__device__ __forceinline__ float bhi(unsigned w) { return __uint_as_float(w & 0xffff0000u); }
template <int CTRL> __device__ __forceinline__ float dppf(float v) { return __int_as_float(__builtin_amdgcn_update_dpp(0, __float_as_int(v), CTRL, 0xf, 0xf, true)); }
__device__ __forceinline__ float wave_sum(float v) {
    v += dppf<0xB1>(v);
    v += dppf<0x4E>(v);
    v += dppf<0x141>(v);
    v += dppf<0x140>(v);
    v += __shfl_xor(v, 16); v += __shfl_xor(v, 32);
    return v;
}
template <int CTRL> __device__ __forceinline__ float dppk(float old, float v) { return __int_as_float(__builtin_amdgcn_update_dpp(__float_as_int(old), __float_as_int(v), CTRL, 0xf, 0xf, false)); }
__device__ __forceinline__ float rdlane(float v, int l) { return __int_as_float(__builtin_amdgcn_readlane(__float_as_int(v), l)); }
__device__ __forceinline__ int crow(int i, int hh) { return (i & 3) + 8 * (i >> 2) + 4 * hh; }
__device__ __forceinline__ bf16x8 pack8(float a0, float a1, float a2, float a3, float a4, float a5, float a6, float a7) {
    v4u p; p.x = pk2(a0, a1); p.y = pk2(a2, a3); p.z = pk2(a4, a5); p.w = pk2(a6, a7); return __builtin_bit_cast(bf16x8, p);
}
__device__ __forceinline__ s16x4 trrd(const LAS unsigned char* p) { return __builtin_bit_cast(s16x4, __builtin_amdgcn_ds_read_tr16_b64_v4i16((LAS v4i16_t*)p)); }
__device__ __forceinline__ bf16x8 cat4(s16x4 lo, s16x4 hi) { return __builtin_shufflevector(lo, hi, 0, 1, 2, 3, 4, 5, 6, 7); }

struct Args { const float* in[26]; float* out; unsigned char* ws; int ph_lo, ph_hi; };

constexpr size_t O_YP = 0, O_YS = O_YP + (size_t)MP * DM, O_PCKV = O_YS + (size_t)MS * DM, O_PKR = O_PCKV + (size_t)2 * MP * 512, O_PC = O_PKR + (size_t)2 * MP * 64,
                 O_PN = O_PC + (size_t)2 * 8 * 4 * 256 * 128, O_PM = O_PN + (size_t)2 * 8 * 4 * 128, O_PR = O_PM + 64, O_SCKV = O_PR + (size_t)2 * 8 * 4 * 128 * 256,
                 O_SKR = O_SCKV + (size_t)2 * MS * 512, O_SC = O_SKR + (size_t)2 * MS * 64, O_SN = O_SC + (size_t)2 * 8 * 4 * 256 * 128, O_SM = O_SN + (size_t)2 * 8 * 4 * 128,
                 O_SR = O_SM + 64, O_END = O_SR + (size_t)2 * 8 * 4 * 128 * 256;

__device__ __forceinline__ int zsrc(int n) {
    if (n < 3072) return n;
    if (n < 6144) return n - 3072 + 4168;
    if (n < 6400) { const int j = n - 6144; return j < 8 ? 3072 + j : -1; }
    const int m = n - 6400;
    if (m < 1024) return 3080 + m;
    if (m < 1280) { const int j = m - 1024; return j < 64 ? 4104 + j : -1; }
    return 7240 + (m - 1280);
}
__device__ __forceinline__ int srccol(int mode, int n) {
    switch (mode) {
        case 0: return zsrc(n);
        case 1: return ((n & 255) < 128) ? 128 * (n >> 8) + (n & 127) : DFF + 128 * (n >> 8) + (n & 127);
        case 3: return (n >> 7) * 256 + (n & 127);
        case 4: return (n >> 7) * 256 + 128 + (n & 127);
        default: return n;
    }
}
__device__ __forceinline__ void transpose_item(const float* W, int Nsrc, bf16* WT, int ldd, int koff, int mode, int nblk, LAS float* scr, int item, int lane) {
    const int kb = item / nblk, nb = item % nblk, k0 = 64 * kb, n0 = 32 * nb;
    const int sc = srccol(mode, n0 + (lane & 31));
    float wv[32];
#pragma unroll
    for (int i = 0; i < 32; ++i) { const int kk = 2 * i + (lane >> 5); wv[i] = sc >= 0 ? __builtin_nontemporal_load(W + (size_t)(k0 + kk) * Nsrc + sc) : 0.f; }
#pragma unroll
    for (int i = 0; i < 32; ++i) { const int kk = 2 * i + (lane >> 5); scr[kk * 33 + (lane & 31)] = wv[i]; }
    asm volatile("s_waitcnt lgkmcnt(0)" ::: "memory");
    const int c = lane & 7;
#pragma unroll
    for (int j = 0; j < 4; ++j) { const int n = (lane >> 3) + 8 * j; const LAS float* s = scr + (8 * c) * 33 + n;
        v4u o; o.x = pk2(s[0 * 33], s[1 * 33]); o.y = pk2(s[2 * 33], s[3 * 33]); o.z = pk2(s[4 * 33], s[5 * 33]); o.w = pk2(s[6 * 33], s[7 * 33]);
        *(v4u*)(WT + (size_t)(n0 + n) * ldd + koff + k0 + 8 * c) = o; }
    asm volatile("s_waitcnt lgkmcnt(0)" ::: "memory");
}
__device__ __forceinline__ void rms_row2_to_bf16(const float* xa, const float* xb, const float* g, bf16* oa, bf16* ob, int lane) {
    f32x4 va[8], vb[8]; float sa = 0.f, sb = 0.f;
#pragma unroll
    for (int j = 0; j < 8; ++j) { va[j] = __builtin_nontemporal_load((const f32x4*)(xa + 4 * lane + 256 * j)); vb[j] = __builtin_nontemporal_load((const f32x4*)(xb + 4 * lane + 256 * j)); }
#pragma unroll
    for (int j = 0; j < 8; ++j) { sa += (va[j].x * va[j].x + va[j].y * va[j].y) + (va[j].z * va[j].z + va[j].w * va[j].w); sb += (vb[j].x * vb[j].x + vb[j].y * vb[j].y) + (vb[j].z * vb[j].z + vb[j].w * vb[j].w); }
    const float ra = rsqrtf(wave_sum(sa) * (1.f / DM) + EPS), rb = rsqrtf(wave_sum(sb) * (1.f / DM) + EPS);
#pragma unroll
    for (int j = 0; j < 8; ++j) { const f32x4 gg = *(const f32x4*)(g + 4 * lane + 256 * j);
        v2u o; o.x = pk2(va[j].x * ra * gg.x, va[j].y * ra * gg.y); o.y = pk2(va[j].z * ra * gg.z, va[j].w * ra * gg.w); *(v2u*)(oa + 4 * lane + 256 * j) = o;
        v2u q; q.x = pk2(vb[j].x * rb * gg.x, vb[j].y * rb * gg.y); q.y = pk2(vb[j].z * rb * gg.z, vb[j].w * rb * gg.w); *(v2u*)(ob + 4 * lane + 256 * j) = q; }
}
__device__ __forceinline__ void rms_row_to_bf16(const float* xrow, const float* g, bf16* orow, int lane) {
    f32x4 v[8]; float s = 0.f;
#pragma unroll
    for (int j = 0; j < 8; ++j) { v[j] = __builtin_nontemporal_load((const f32x4*)(xrow + 4 * lane + 256 * j)); s += (v[j].x * v[j].x + v[j].y * v[j].y) + (v[j].z * v[j].z + v[j].w * v[j].w); }
    const float r = rsqrtf(wave_sum(s) * (1.f / DM) + EPS);
#pragma unroll
    for (int j = 0; j < 8; ++j) { const f32x4 gg = *(const f32x4*)(g + 4 * lane + 256 * j);
        v2u o; o.x = pk2(v[j].x * r * gg.x, v[j].y * r * gg.y); o.y = pk2(v[j].z * r * gg.z, v[j].w * r * gg.w); *(v2u*)(orow + 4 * lane + 256 * j) = o; }
}

struct Ctx {
    LAS unsigned char* lds; int tid, lane, wave, G, bid;
    float* out; unsigned char* ws;
};
__device__ __forceinline__ const float* cin(const Ctx& C, int i) {
    const LAS unsigned* p = (const LAS unsigned*)(C.lds + MISC_OFF + 64 + 8 * i);
    const unsigned lo = __builtin_amdgcn_readfirstlane(p[0]), hi = __builtin_amdgcn_readfirstlane(p[1]);
    return (const float*)(((unsigned long long)hi << 32) | lo);
}
#define WPTR(layer, off) ((bf16*)(C.ws + WS_W + (size_t)(layer) * W_LAYER + (off)))
#define GPTR(off) ((bf16*)(C.ws + WS_G + (off)))

constexpr int W_I_IN = (DM / 64) * (ZW / 32), W_I_GU = (DM / 64) * (2 * DFF / 32), W_I_DN = (DFF / 64) * (DM / 32), W_I_O = (DM / 64) * (DM / 32), W_I_UP = (1024 / 64) * (DM / 32),
              W_I_UQ = (512 / 64) * (1536 / 32), W_I_UK = (512 / 64) * (1024 / 32);
constexpr int W_NITEMS = W_I_IN + W_I_GU + W_I_DN + W_I_O + 3 * W_I_UP + W_I_UQ + 2 * W_I_UK;
__device__ __forceinline__ void weight_item(Ctx& C, int layer, int it, LAS float* scr) {
    int r = it;
    if (r < W_I_IN) { transpose_item(cin(C, 9) + (size_t)layer * DM * DIN, DIN, WPTR(layer, WO_IN), DM, 0, 0, ZW / 32, scr, r, C.lane); return; } r -= W_I_IN;
    if (r < W_I_GU) { transpose_item(cin(C, 23) + (size_t)layer * DM * 2 * DFF, 2 * DFF, WPTR(layer, WO_GU), DM, 0, 1, 2 * DFF / 32, scr, r, C.lane); return; } r -= W_I_GU;
    if (r < W_I_DN) { transpose_item(cin(C, 24) + (size_t)layer * DFF * DM, DM, WPTR(layer, WO_DOWN), DFF, 0, 2, DM / 32, scr, r, C.lane); return; } r -= W_I_DN;
    if (r < W_I_O) { transpose_item(cin(C, 20) + (size_t)layer * DM * DM, DM, WPTR(layer, WO_O), DM, 0, 2, DM / 32, scr, r, C.lane); return; } r -= W_I_O;
    if (r < W_I_UP) { transpose_item(cin(C, 12) + (size_t)layer * 1024 * DM, DM, WPTR(layer, WO_UP), YW, 0, 2, DM / 32, scr, r, C.lane); return; } r -= W_I_UP;
    if (r < W_I_UP) { transpose_item(cin(C, 17) + (size_t)layer * 1024 * DM, DM, WPTR(layer, WO_UP), YW, 1024, 2, DM / 32, scr, r, C.lane); return; } r -= W_I_UP;
    if (r < W_I_UP) { transpose_item(cin(C, 19) + (size_t)layer * 1024 * DM, DM, WPTR(layer, WO_UP), YW, 2048, 2, DM / 32, scr, r, C.lane); return; } r -= W_I_UP;
    if (r < W_I_UQ) { transpose_item(cin(C, 14) + (size_t)layer * 512 * 1536, 1536, WPTR(layer, WO_UQ), 512, 0, 2, 1536 / 32, scr, r, C.lane); return; } r -= W_I_UQ;
    if (r < W_I_UK) { transpose_item(cin(C, 16) + (size_t)layer * 512 * 2048, 2048, WPTR(layer, WO_UK), 512, 0, 3, 1024 / 32, scr, r, C.lane); return; } r -= W_I_UK;
    transpose_item(cin(C, 16) + (size_t)layer * 512 * 2048, 2048, WPTR(layer, WO_V), 512, 0, 4, 1024 / 32, scr, r, C.lane);
}

__device__ __forceinline__ void p0_prologue(Ctx& C) {
    asm volatile("" : "+v"(C.lane)); C.tid = C.wave * 64 + C.lane;
    LAS float* scr = (LAS float*)(C.lds + C.wave * 16384);
    int gw = C.bid * NWAVES + C.wave; const int NGW = C.G * NWAVES;
    for (int it = gw; it < W_I_IN + W_I_UQ + 2 * W_I_UK; it += NGW) weight_item(C, 0, it < W_I_IN ? it : it - W_I_IN + (W_NITEMS - W_I_UQ - 2 * W_I_UK), scr);
    for (int layer = 0; layer < 2; ++layer) {
        float* bz = (float*)(C.ws + WS_W + (size_t)layer * W_LAYER + WO_BIAS);
        for (int n = C.bid * NTHR + C.tid; n < ZW; n += C.G * NTHR) { const int s = zsrc(n); bz[n] = s >= 0 ? cin(C, 10)[(size_t)layer * DIN + s] : 0.f; }
    }
    {
        float* ca = (float*)(C.ws + WS_ROPEA); float* sa = ca + 4096 * 32; float* cr = (float*)(C.ws + WS_ROPER); float* sr = cr + 4096 * 64;
        for (int e = C.bid * NTHR + C.tid; e < 4096 * 96; e += C.G * NTHR) {
            int pos, i, d; float* cp; float* sp;
            if (e < 4096 * 32) { pos = e >> 5; i = e & 31; d = 64; cp = ca + e; sp = sa + e; } else { const int e2 = e - 4096 * 32; pos = e2 >> 6; i = e2 & 63; d = 128; cp = cr + e2; sp = sr + e2; }
            const float inv = 1.0f / powf(10000.0f, (float)(2 * i) / (float)d);
            const float ang = (float)pos * inv;
            const double a = (double)ang; const double k = rint(a * 0.15915494309189535); const double red = a - k * 6.283185307179586;
            const float rf = (float)red;
            *cp = __cosf(rf); *sp = __sinf(rf);
        }
    }
    bf16* XB = (bf16*)(C.ws + WS_XB);
    for (int m = gw; m < MT; m += 2 * NGW) {
        const int m2 = m + NGW; const bool has2 = m2 < MT;
        const float* xr = m < MP ? cin(C, 0) + (size_t)m * DM : cin(C, 1) + (size_t)(m - MP) * DM;
        const float* xr2 = has2 ? (m2 < MP ? cin(C, 0) + (size_t)m2 * DM : cin(C, 1) + (size_t)(m2 - MP) * DM) : xr;
        rms_row2_to_bf16(xr, xr2, cin(C, 8), XB + (size_t)m * DM, XB + (size_t)(has2 ? m2 : m) * DM, C.lane); }
}

__device__ __forceinline__ void pe_phase(Ctx& C, int layer, int g) {
    asm volatile("" : "+v"(C.lane)); C.tid = C.wave * 64 + C.lane;
    const int gw = C.bid * NWAVES + C.wave, NGW = C.G * NWAVES, lane = C.lane;
    const bf16* Z = GPTR(GO_Z); bf16* QN = GPTR(GO_QN); bf16* CK = GPTR(GO_CK); bf16* KR = GPTR(GO_KR);
    const float* gqa = cin(C, 13) + layer * 512; const float* gkv = cin(C, 15) + layer * 512;
    const float* ca = (const float*)(C.ws + WS_ROPEA); const float* sa = ca + 4096 * 32;
    const int rows = grp_rows(g), r0 = grp_row0(g);
    for (int lr = gw; lr < rows; lr += NGW) {
        const int m = r0 + lr; const bool smp = m >= MP;
        const int b = smp ? (m - MP) >> 6 : m >> 12, s = smp ? (m - MP) & 63 : m & 4095, pos = smp ? PAST + s : s;
        const int ckrow = smp ? 16384 + (m - MP) : lr;
        const bf16* zr = Z + (size_t)lr * ZRW;
        {
            const v4u w = *(const v4u*)(zr + ZR_DQ + 8 * lane);
            float v[8] = {blo(w.x), bhi(w.x), blo(w.y), bhi(w.y), blo(w.z), bhi(w.z), blo(w.w), bhi(w.w)}; float ss = 0.f;
#pragma unroll
            for (int k = 0; k < 8; ++k) ss += v[k] * v[k];
            const float r = rsqrtf(wave_sum(ss) * (1.f / 512.f) + EPS);
            const f32x4 g0 = *(const f32x4*)(gqa + 8 * lane), g1 = *(const f32x4*)(gqa + 8 * lane + 4);
            v4u o; o.x = pk2(v[0] * r * g0.x, v[1] * r * g0.y); o.y = pk2(v[2] * r * g0.z, v[3] * r * g0.w); o.z = pk2(v[4] * r * g1.x, v[5] * r * g1.y); o.w = pk2(v[6] * r * g1.z, v[7] * r * g1.w);
            *(v4u*)(QN + (size_t)lr * 512 + 8 * lane) = o;
        }
        {
            const v4u w = *(const v4u*)(zr + ZR_DKV + 8 * lane);
            float v[8] = {blo(w.x), bhi(w.x), blo(w.y), bhi(w.y), blo(w.z), bhi(w.z), blo(w.w), bhi(w.w)}; float ss = 0.f;
#pragma unroll
            for (int k = 0; k < 8; ++k) ss += v[k] * v[k];
            const float r = rsqrtf(wave_sum(ss) * (1.f / 512.f) + EPS);
            const f32x4 g0 = *(const f32x4*)(gkv + 8 * lane), g1 = *(const f32x4*)(gkv + 8 * lane + 4);
            f32x4 o0 = {v[0] * r * g0.x, v[1] * r * g0.y, v[2] * r * g0.z, v[3] * r * g0.w}, o1 = {v[4] * r * g1.x, v[5] * r * g1.y, v[6] * r * g1.z, v[7] * r * g1.w};
            float* op = smp ? C.out + O_SCKV + ((size_t)(layer * 8 + b) * DSEQ + s) * 512 : C.out + O_PCKV + ((size_t)(layer * 8 + b) * SEQ + s) * 512;
            __builtin_nontemporal_store(o0, (f32x4*)(op + 8 * lane)); __builtin_nontemporal_store(o1, (f32x4*)(op + 8 * lane + 4));
            v4u o; o.x = pk2(o0.x, o0.y); o.y = pk2(o0.z, o0.w); o.z = pk2(o1.x, o1.y); o.w = pk2(o1.z, o1.w);
            *(v4u*)(CK + (size_t)ckrow * 512 + 8 * lane) = o;
        }
        if (lane < 32) {
            const float x1 = bf2f(zr[ZR_KR + lane]), x2 = bf2f(zr[ZR_KR + 32 + lane]);
            const float c = ca[pos * 32 + lane], sn = sa[pos * 32 + lane];
            const float o1 = x1 * c - x2 * sn, o2 = x1 * sn + x2 * c;
            float* op = smp ? C.out + O_SKR + ((size_t)(layer * 8 + b) * DSEQ + s) * 64 : C.out + O_PKR + ((size_t)(layer * 8 + b) * SEQ + s) * 64;
            op[lane] = o1; op[32 + lane] = o2;
            KR[(size_t)ckrow * 64 + lane] = (bf16)f2bf(o1); KR[(size_t)ckrow * 64 + 32 + lane] = (bf16)f2bf(o2);
        }
    }
    if (g == 2) {
        const float* cc = cin(C, 2) + (size_t)layer * 8 * PAST * 512; const float* ck = cin(C, 3) + (size_t)layer * 8 * PAST * 64;
        { const size_t st = (size_t)C.G * NTHR, n = (size_t)8192 * 128;
          for (size_t e = (size_t)C.bid * NTHR + C.tid; e < n; e += 4 * st) { f32x4 v[4];
#pragma unroll
              for (int u = 0; u < 4; ++u) if (e + u * st < n) v[u] = __builtin_nontemporal_load((const f32x4*)(cc + (e + u * st) * 4));
#pragma unroll
              for (int u = 0; u < 4; ++u) if (e + u * st < n) { v2u o; o.x = pk2(v[u].x, v[u].y); o.y = pk2(v[u].z, v[u].w); *(v2u*)(CK + (size_t)8192 * 512 + (e + u * st) * 4) = o; } } }
        for (size_t e = (size_t)C.bid * NTHR + C.tid; e < (size_t)8192 * 16; e += (size_t)C.G * NTHR) { const f32x4 v = __builtin_nontemporal_load((const f32x4*)(ck + e * 4)); v2u o; o.x = pk2(v.x, v.y); o.y = pk2(v.z, v.w); *(v2u*)(KR + (size_t)8192 * 64 + e * 4) = o; }
    }
}

__device__ __forceinline__ void px_phase(Ctx& C, const bf16* T, const bf16* TP, int nsplit, const float* gpost, const float* gnext, bool first_layer_input) {
    asm volatile("" : "+v"(C.lane)); C.tid = C.wave * 64 + C.lane;
    const int gw = C.bid * NWAVES + C.wave, NGW = C.G * NWAVES, lane = C.lane;
    bf16* XB = (bf16*)(C.ws + WS_XB);
    int m0 = gw;
    if (((MP / NGW) & 1) == 0 && (MP % NGW) == 0) {
        for (; m0 < MP; m0 += 2 * NGW) {
            f32x4 t[2][8], x[2][8];
#pragma unroll
            for (int rr = 0; rr < 2; ++rr) { const int m = m0 + rr * NGW;
                const float* xr = first_layer_input ? cin(C, 0) + (size_t)m * DM : C.out + (size_t)m * DM;
#pragma unroll
                for (int j = 0; j < 8; ++j) { const v2u w = __builtin_nontemporal_load((const v2u*)(T + (size_t)m * DM + 4 * lane + 256 * j)); t[rr][j] = (f32x4){blo(w.x), bhi(w.x), blo(w.y), bhi(w.y)};
                    x[rr][j] = __builtin_nontemporal_load((const f32x4*)(xr + 4 * lane + 256 * j)); } }
#pragma unroll
            for (int rr = 0; rr < 2; ++rr) { const int m = m0 + rr * NGW; float* xo = C.out + (size_t)m * DM; float ts = 0.f;
#pragma unroll
                for (int j = 0; j < 8; ++j) ts += (t[rr][j].x * t[rr][j].x + t[rr][j].y * t[rr][j].y) + (t[rr][j].z * t[rr][j].z + t[rr][j].w * t[rr][j].w);
                const float r = rsqrtf(wave_sum(ts) * (1.f / DM) + EPS); float ss = 0.f;
#pragma unroll
                for (int j = 0; j < 8; ++j) { const int idx = 4 * lane + 256 * j; const f32x4 gg = *(const f32x4*)(gpost + idx); f32x4 v;
                    v.x = x[rr][j].x + t[rr][j].x * r * gg.x; v.y = x[rr][j].y + t[rr][j].y * r * gg.y; v.z = x[rr][j].z + t[rr][j].z * r * gg.z; v.w = x[rr][j].w + t[rr][j].w * r * gg.w;
                    __builtin_nontemporal_store(v, (f32x4*)(xo + idx)); t[rr][j] = v; ss += (v.x * v.x + v.y * v.y) + (v.z * v.z + v.w * v.w); }
                if (gnext) { const float r2 = rsqrtf(wave_sum(ss) * (1.f / DM) + EPS);
#pragma unroll
                    for (int j = 0; j < 8; ++j) { const int idx = 4 * lane + 256 * j; const f32x4 gg = *(const f32x4*)(gnext + idx);
                        v2u o; o.x = pk2(t[rr][j].x * r2 * gg.x, t[rr][j].y * r2 * gg.y); o.y = pk2(t[rr][j].z * r2 * gg.z, t[rr][j].w * r2 * gg.w); *(v2u*)(XB + (size_t)m * DM + idx) = o; } } }
        }
    }
    for (int m = m0; m < MT; m += NGW) {
        const float* xr = first_layer_input ? (m < MP ? cin(C, 0) + (size_t)m * DM : cin(C, 1) + (size_t)(m - MP) * DM) : C.out + (size_t)m * DM;
        float* xo = C.out + (size_t)m * DM;
        f32x4 t[8]; float ts = 0.f;
        if (m < MP) {
#pragma unroll
            for (int j = 0; j < 8; ++j) { const v2u w = __builtin_nontemporal_load((const v2u*)(T + (size_t)m * DM + 4 * lane + 256 * j)); t[j] = (f32x4){blo(w.x), bhi(w.x), blo(w.y), bhi(w.y)}; }
        } else {
#pragma unroll
            for (int j = 0; j < 8; ++j) t[j] = (f32x4){0.f, 0.f, 0.f, 0.f};
            for (int s0 = 0; s0 < nsplit; s0 += 4) {
                v2u wq[4][8];
#pragma unroll
                for (int u = 0; u < 4; ++u) if (s0 + u < nsplit) {
#pragma unroll
                    for (int j = 0; j < 8; ++j) wq[u][j] = __builtin_nontemporal_load((const v2u*)(TP + ((size_t)(s0 + u) * MS + (m - MP)) * DM + 4 * lane + 256 * j)); }
#pragma unroll
                for (int u = 0; u < 4; ++u) if (s0 + u < nsplit) {
#pragma unroll
                    for (int j = 0; j < 8; ++j) { const v2u w = wq[u][j]; t[j].x += blo(w.x); t[j].y += bhi(w.x); t[j].z += blo(w.y); t[j].w += bhi(w.y); } }
            }
        }
#pragma unroll
        for (int j = 0; j < 8; ++j) ts += (t[j].x * t[j].x + t[j].y * t[j].y) + (t[j].z * t[j].z + t[j].w * t[j].w);
        const float r = rsqrtf(wave_sum(ts) * (1.f / DM) + EPS);
        float ss = 0.f;
#pragma unroll
        for (int j = 0; j < 8; ++j) { const int idx = 4 * lane + 256 * j; const f32x4 x = __builtin_nontemporal_load((const f32x4*)(xr + idx)); const f32x4 gg = *(const f32x4*)(gpost + idx);
            t[j].x = x.x + t[j].x * r * gg.x; t[j].y = x.y + t[j].y * r * gg.y; t[j].z = x.z + t[j].z * r * gg.z; t[j].w = x.w + t[j].w * r * gg.w;
            __builtin_nontemporal_store(t[j], (f32x4*)(xo + idx)); ss += (t[j].x * t[j].x + t[j].y * t[j].y) + (t[j].z * t[j].z + t[j].w * t[j].w); }
        if (gnext) {
            const float r2 = rsqrtf(wave_sum(ss) * (1.f / DM) + EPS);
#pragma unroll
            for (int j = 0; j < 8; ++j) { const int idx = 4 * lane + 256 * j; const f32x4 gg = *(const f32x4*)(gnext + idx);
                v2u o; o.x = pk2(t[j].x * r2 * gg.x, t[j].y * r2 * gg.y); o.y = pk2(t[j].z * r2 * gg.z, t[j].w * r2 * gg.w); *(v2u*)(XB + (size_t)m * DM + idx) = o; }
        }
    }
}

constexpr int AT_KROW = 400, AT_VROW = 136, AT_VS = 64 * AT_KROW, AT_BUF = AT_VS + 128 * AT_VROW;
static_assert(AT_BUF % 16 == 0 && 2 * AT_BUF <= 131072, "attention LDS");
__device__ __forceinline__ void attn_unit(Ctx& C, int g, bool sample, int bsel, int hd, int qt) {
    int lane_ = C.lane; asm volatile("" : "+v"(lane_)); asm volatile("" : "+s"(C.ws), "+s"(C.out));
    const int w = C.wave, lane = lane_, tid = w * 64 + lane, r = lane & 31, hh = lane >> 5;
    LAS unsigned char* lds = C.lds;
    const bf16* QA = GPTR(GO_QA); const bf16* KN = GPTR(GO_KN); const bf16* KR = GPTR(GO_KR); const bf16* VT = GPTR(GO_VT); bf16* Y = GPTR(GO_Y);
    const int ldv = grp_ck(g);
    const int qrow0 = sample ? 8192 + bsel * 64 : bsel * 4096 + qt * 256;
    const int pos0 = sample ? PAST : qt * 256;
    const int ntiles = sample ? 17 : 4 * qt + 4;
    const bool wact = sample ? (w < 2) : true;
    const int jlim = sample ? 16 : 4 * qt + (w >> 1);
    v4u kreg[3], vreg[2];
#define AT_TROW(j) (sample ? ((j) < 16 ? 8192 + bsel * 1024 + 64 * (j) : 16384 + bsel * 64) : bsel * 4096 + 64 * (j))
#define AT_LOAD(j) do { const int trow_ = AT_TROW(j); \
        _Pragma("unroll") for (int i_ = 0; i_ < 3; ++i_) { const int c_ = tid + 512 * i_, key_ = c_ / 24, ch_ = c_ - 24 * key_; \
            kreg[i_] = ch_ < 16 ? *(const v4u*)((const char*)(KN + (size_t)trow_ * 1024 + hd * 128) + (unsigned)(key_ * 1024 + 8 * ch_) * 2u) : *(const v4u*)((const char*)(KR + (size_t)trow_ * 64) + (unsigned)(key_ * 64 + 8 * (ch_ - 16)) * 2u); } \
        _Pragma("unroll") for (int i_ = 0; i_ < 2; ++i_) { const int c_ = tid + 512 * i_, dv_ = c_ >> 3, ch_ = c_ & 7; \
            vreg[i_] = *(const v4u*)((const char*)(VT + (size_t)(hd * 128) * ldv + trow_) + (unsigned)(dv_ * ldv + 8 * ch_) * 2u); } } while (0)
#define AT_STORE(bufo) do { \
        _Pragma("unroll") for (int i_ = 0; i_ < 3; ++i_) { const int c_ = tid + 512 * i_, key_ = c_ / 24, ch_ = c_ - 24 * key_; *(LAS v4u*)(lds + (bufo) + key_ * AT_KROW + 16 * ch_) = kreg[i_]; } \
        _Pragma("unroll") for (int i_ = 0; i_ < 2; ++i_) { const int c_ = tid + 512 * i_, dv_ = c_ >> 3, ch_ = c_ & 7; \
            *(LAS v2u*)(lds + (bufo) + AT_VS + dv_ * AT_VROW + 16 * ch_) = (v2u){vreg[i_].x, vreg[i_].y}; *(LAS v2u*)(lds + (bufo) + AT_VS + dv_ * AT_VROW + 16 * ch_ + 8) = (v2u){vreg[i_].z, vreg[i_].w}; } } while (0)
    AT_LOAD(0);
    bf16x8 qf[12];
#pragma unroll
    for (int s = 0; s < 12; ++s) qf[s] = (bf16x8){0, 0, 0, 0, 0, 0, 0, 0};
    if (wact) {
        const bf16* qp = QA + (size_t)(qrow0 + 32 * w + r) * 1536 + hd * 192 + 8 * hh;
#pragma unroll
        for (int s = 0; s < 8; ++s) qf[s] = *(const bf16x8*)(qp + 16 * s);
        const int pos = pos0 + 32 * w + r;
        const float* ca = (const float*)(C.ws + WS_ROPEA); const float* sa = ca + 4096 * 32;
#pragma unroll
        for (int sp = 0; sp < 2; ++sp) {
            const bf16x8 x1 = *(const bf16x8*)(qp + 128 + 16 * sp), x2 = *(const bf16x8*)(qp + 160 + 16 * sp);
            const float* ct = ca + pos * 32 + 16 * sp + 8 * hh; const float* st = sa + pos * 32 + 16 * sp + 8 * hh;
            float o1[8], o2[8];
#pragma unroll
            for (int j = 0; j < 8; ++j) { const float a = bf2f((unsigned short)x1[j]), b = bf2f((unsigned short)x2[j]), c = ct[j], s = st[j]; o1[j] = a * c - b * s; o2[j] = a * s + b * c; }
            qf[8 + sp] = pack8(o1[0], o1[1], o1[2], o1[3], o1[4], o1[5], o1[6], o1[7]);
            qf[10 + sp] = pack8(o2[0], o2[1], o2[2], o2[3], o2[4], o2[5], o2[6], o2[7]);
        }
    }
    f32x16 ot[4];
#pragma unroll
    for (int db = 0; db < 4; ++db)
#pragma unroll
        for (int i = 0; i < 16; ++i) ot[db][i] = 0.f;
    float mrun = -1e30f, lrun = 0.f;
    const float CS = 0.07216878364870322f * 1.4426950408889634f;
    AT_STORE(0);
    __syncthreads();
    if (ntiles > 1) AT_LOAD(1);
    for (int j = 0; j < ntiles; ++j) {
        const int bo = (j & 1) * AT_BUF;
        if (wact && j <= jlim) {
            f32x16 s0, s1;
#pragma unroll
            for (int i = 0; i < 16; ++i) { s0[i] = 0.f; s1[i] = 0.f; }
#pragma unroll
            for (int s = 0; s < 12; ++s) {
                const bf16x8 a0 = *(const LAS bf16x8*)(lds + bo + r * AT_KROW + (16 * s + 8 * hh) * 2);
                const bf16x8 a1 = *(const LAS bf16x8*)(lds + bo + (32 + r) * AT_KROW + (16 * s + 8 * hh) * 2);
                s0 = MFMA32(a0, qf[s], s0); s1 = MFMA32(a1, qf[s], s1);
            }
            float mx = s0[0];
#pragma unroll
            for (int i = 0; i < 16; ++i) { mx = fmaxf(mx, s0[i]); mx = fmaxf(mx, s1[i]); }
            mx = fmaxf(mx, __shfl_xor(mx, 32));
            const float mnew = fmaxf(mrun, mx * CS);
            const float alpha = __builtin_amdgcn_exp2f(mrun - mnew);
            mrun = mnew; lrun *= alpha;
            if (__builtin_amdgcn_ballot_w64(alpha != 1.0f) != 0ull) {
#pragma unroll
                for (int db = 0; db < 4; ++db) ot[db] = ot[db] * alpha;
            }
#pragma unroll
            for (int i = 0; i < 16; ++i) { s0[i] = __builtin_amdgcn_exp2f(s0[i] * CS - mnew); s1[i] = __builtin_amdgcn_exp2f(s1[i] * CS - mnew); lrun += s0[i] + s1[i]; }
#pragma unroll
            for (int sub = 0; sub < 2; ++sub)
#pragma unroll
                for (int sp = 0; sp < 2; ++sp) {
                    const bf16x8 pf = sub == 0 ? pack8(s0[8 * sp], s0[8 * sp + 1], s0[8 * sp + 2], s0[8 * sp + 3], s0[8 * sp + 4], s0[8 * sp + 5], s0[8 * sp + 6], s0[8 * sp + 7])
                                               : pack8(s1[8 * sp], s1[8 * sp + 1], s1[8 * sp + 2], s1[8 * sp + 3], s1[8 * sp + 4], s1[8 * sp + 5], s1[8 * sp + 6], s1[8 * sp + 7]);
#pragma unroll
                    for (int db = 0; db < 4; ++db) {
                        const s16x4 lo = *(const LAS s16x4*)(lds + bo + AT_VS + (32 * db + r) * AT_VROW + (32 * sub + 16 * sp + 4 * hh) * 2);
                        const s16x4 hi = *(const LAS s16x4*)(lds + bo + AT_VS + (32 * db + r) * AT_VROW + (32 * sub + 16 * sp + 8 + 4 * hh) * 2);
                        ot[db] = MFMA32(cat4(lo, hi), pf, ot[db]);
                    }
                }
        }
        if (j + 1 < ntiles) { AT_STORE(AT_BUF - bo); }
        __syncthreads();
        if (j + 2 < ntiles) AT_LOAD(j + 2);
    }
    if (wact) {
        const float l = lrun + __shfl_xor(lrun, 32); const float inv = 1.0f / l;
        bf16* yp = Y + (size_t)(grp_row0(g) + qrow0 + 32 * w + r) * YW + 1024 + hd * 128 + 4 * hh;
#pragma unroll
        for (int db = 0; db < 4; ++db)
#pragma unroll
            for (int q = 0; q < 4; ++q) { v2u o; o.x = pk2(ot[db][4 * q] * inv, ot[db][4 * q + 1] * inv); o.y = pk2(ot[db][4 * q + 2] * inv, ot[db][4 * q + 3] * inv); *(v2u*)(yp + 32 * db + 8 * q) = o; }
    }
    __syncthreads();
#undef AT_TROW
#undef AT_LOAD
#undef AT_STORE
}

constexpr int SC_QROW = 272, SC_VROW = 576, SC_KCROW = 320, SC_HROW = 528;
constexpr int SC_QS = 0, SC_KS = 17408, SC_VS = 34816, SC_KSC = SC_VS + 64 * SC_VROW, SC_HT = SC_KSC + 64 * SC_KCROW, SC_SM = SC_HT + 64 * SC_HROW;
constexpr int SM_A = SC_SM, SM_MX = SM_A + 256, SM_PS = SM_MX + 256, SM_EM = SM_PS + 256, SM_WS = SM_EM + 256, SM_NQ = SM_WS + 256, SM_NV = SM_NQ + 256, SM_SC = SM_NV + 512, SM_RDW = SM_SC + 64;
static_assert(SM_RDW + 2048 <= 131072 && SC_SM % 16 == 0, "scan LDS");
#ifndef PROBE_SKIP
#define PROBE_SKIP 0
#endif
template <bool RET, bool sample, bool DRY = false>
__device__ __forceinline__ void scan_unit(Ctx& C, int layer, int bsel, int hd, const unsigned* ready = nullptr, unsigned need = 0u) {
    constexpr int SKIP = DRY ? PROBE_SKIP : 0;
    int w = C.wave; int lane = C.lane, tid = C.tid, r = lane & 31, hh = lane >> 5;
    int q4 = (lane & 15) >> 2, p4 = lane & 3, blk = (lane >> 4) & 1;
#define SC_LAUNDER() do { asm volatile("" : "+v"(lane)); asm volatile("" : "+s"(w)); tid = w * 64 + lane; r = lane & 31; hh = lane >> 5; q4 = (lane & 15) >> 2; p4 = lane & 3; blk = (lane >> 4) & 1; } while (0)
    SC_LAUNDER(); asm volatile("" : "+s"(C.ws), "+s"(C.out));
    LAS unsigned char* lds = C.lds;
    LAS float* A_ = (LAS float*)(lds + SM_A); LAS float* MX_ = (LAS float*)(lds + SM_MX); LAS float* PS_ = (LAS float*)(lds + SM_PS); LAS float* EM_ = (LAS float*)(lds + SM_EM);
    LAS float* WS_ = (LAS float*)(lds + SM_WS); LAS float* NQ_ = (LAS float*)(lds + SM_NQ); LAS float* NV_ = (LAS float*)(lds + SM_NV); LAS float* SC_ = (LAS float*)(lds + SM_SC);
    LAS float* RDW_ = (LAS float*)(lds + SM_RDW) + 64 * w;
    const bf16* Z = GPTR(GO_ZS); bf16* Y = GPTR(GO_Y);
    const int v0 = 32 * w;
    const int bglob = bsel;
    const int nch = sample ? 1 : 64;
    const size_t sidx = (size_t)(layer * 8 + bglob) * 4 + hd;
    const float KSCALE = 0.08838834764831845f;
    f32x16 Cacc[4];
#pragma unroll
    for (int db = 0; db < 4; ++db)
#pragma unroll
        for (int i = 0; i < 16; ++i) Cacc[db][i] = 0.f;
    if (sample) {
        if (!RET) {
            const float* c0 = cin(C, 4) + sidx * 256 * 128 + (size_t)(v0 + r) * 128;
#pragma unroll
            for (int db = 0; db < 4; ++db)
#pragma unroll
                for (int q = 0; q < 4; ++q) { const f32x4 t = *(const f32x4*)(c0 + 32 * db + 8 * q + 4 * hh); Cacc[db][4 * q] = t.x; Cacc[db][4 * q + 1] = t.y; Cacc[db][4 * q + 2] = t.z; Cacc[db][4 * q + 3] = t.w; }
        } else {
            const float* r0p = cin(C, 7) + sidx * 128 * 256 + v0 + r;
#pragma unroll
            for (int db = 0; db < 4; ++db)
#pragma unroll
                for (int i = 0; i < 16; ++i) Cacc[db][i] = r0p[(size_t)(32 * db + crow(i, hh)) * 256];
        }
    }
    if (!RET) {
        if (tid < 128) NV_[tid] = sample ? cin(C, 5)[sidx * 128 + tid] : 0.f;
        if (tid == 0) SC_[0] = sample ? cin(C, 6)[sidx] : 0.f;
    } else if (w == 0) {
        const float lg = log1pf(-exp2f(-5.0f - (float)hd));
        A_[lane] = -(float)lane * lg * 1.4426950408889634f; MX_[lane] = -(float)lane * lg * 1.4426950408889634f; PS_[lane] = expf((float)(lane + 1) * lg); WS_[lane] = expf((float)(63 - lane) * lg);
        if (lane == 0) SC_[1] = expf(64.0f * lg);
    }
    const float* cr = (const float*)(C.ws + WS_ROPER); const float* sr = cr + 4096 * 64;
    v4u pq[2], pk[2], pv[4]; float pig = 0.f, pfg = 0.f;
#define SC_ZROW(cn) (sample ? MP + bsel * 64 : bsel * 4096 + 64 * (cn))
#define SC_LOAD(cn) do { const char* Zn_ = (const char*)(Z + (size_t)SC_ZROW(cn) * ZSW); \
        if (!RET) { \
            _Pragma("unroll") for (int i_ = 0; i_ < 2; ++i_) { const int cc_ = tid + 512 * i_, row_ = cc_ >> 4, ch_ = cc_ & 15; const unsigned zo_ = (unsigned)(row_ * ZSW + hd * 128 + 8 * ch_) * 2u; \
                pq[i_] = *(const v4u*)(Zn_ + zo_ + ZS_MQ * 2); pk[i_] = *(const v4u*)(Zn_ + zo_ + ZS_MK * 2); } \
            if (w == 0) { const bf16* zr_ = (const bf16*)(Zn_ + (unsigned)(lane * ZSW + ZS_MISC + hd) * 2u); pig = bf2f(zr_[0]); pfg = bf2f(zr_[4]); } \
        } else { \
            const int row_ = tid >> 3, ch_ = tid & 7; const unsigned zo_ = (unsigned)(row_ * ZSW + hd * 128 + 8 * ch_) * 2u; \
            pq[0] = *(const v4u*)(Zn_ + zo_ + ZS_RQ * 2); pq[1] = *(const v4u*)(Zn_ + zo_ + ZS_RQ * 2 + 128); pk[0] = *(const v4u*)(Zn_ + zo_ + ZS_RK * 2); pk[1] = *(const v4u*)(Zn_ + zo_ + ZS_RK * 2 + 128); \
        } \
        _Pragma("unroll") for (int i_ = 0; i_ < 4; ++i_) { const int cc_ = tid + 512 * i_, row_ = cc_ >> 5, ch_ = cc_ & 31; \
            pv[i_] = *(const v4u*)(Zn_ + (unsigned)(row_ * ZSW + (RET ? ZS_RV : ZS_MV) + hd * 256 + 8 * ch_) * 2u); } } while (0)
#define SC_POLL(cn) do { if (ready && w == 0) { const unsigned* rp_ = ready + 16 * (SC_ZROW(cn) >> 8); unsigned sp_ = 0u; \
            while (__hip_atomic_load(rp_, __ATOMIC_RELAXED, __HIP_MEMORY_SCOPE_AGENT) < need) { __builtin_amdgcn_s_sleep(2); if (++sp_ > (1u << 17)) break; } \
            __builtin_amdgcn_fence(__ATOMIC_ACQUIRE, "agent"); asm volatile("s_waitcnt vmcnt(0)" ::: "memory"); } } while (0)
    SC_POLL(0);
    __syncthreads();
    SC_LOAD(0);
    for (int c = 0; c < nch; ++c) {
        const int zrow0 = SC_ZROW(c);
        SC_LAUNDER();
        const char* Zc = (const char*)(Z + (size_t)zrow0 * ZSW); char* Yc = (char*)(Y + (size_t)zrow0 * YW);
        if (!RET) {
#pragma unroll
            for (int i = 0; i < 2; ++i) { const int cc = tid + 512 * i, row = cc >> 4, ch = cc & 15;
                *(LAS v4u*)(lds + SC_QS + row * SC_QROW + 16 * ch) = pq[i]; *(LAS v4u*)(lds + SC_KS + row * SC_QROW + 16 * ch) = pk[i]; }
        } else {
            const int row = tid >> 3, ch = tid & 7;
            const unsigned to = (unsigned)(((sample ? PAST : 64 * c) + row) * 64 + 8 * ch) * 4u;
            f32x4 pcs[2], psn[2];
            pcs[0] = *(const f32x4*)((const char*)cr + to); pcs[1] = *(const f32x4*)((const char*)cr + to + 16); psn[0] = *(const f32x4*)((const char*)sr + to); psn[1] = *(const f32x4*)((const char*)sr + to + 16);
            const float cs[8] = {pcs[0].x, pcs[0].y, pcs[0].z, pcs[0].w, pcs[1].x, pcs[1].y, pcs[1].z, pcs[1].w}, sn[8] = {psn[0].x, psn[0].y, psn[0].z, psn[0].w, psn[1].x, psn[1].y, psn[1].z, psn[1].w};
#pragma unroll
            for (int which = 0; which < 2; ++which) {
                const v4u a = which ? pk[0] : pq[0], b = which ? pk[1] : pq[1];
                const float x1[8] = {blo(a.x), bhi(a.x), blo(a.y), bhi(a.y), blo(a.z), bhi(a.z), blo(a.w), bhi(a.w)}, x2[8] = {blo(b.x), bhi(b.x), blo(b.y), bhi(b.y), blo(b.z), bhi(b.z), blo(b.w), bhi(b.w)};
                const float sc = which ? KSCALE : 1.0f; float o1[8], o2[8];
#pragma unroll
                for (int j = 0; j < 8; ++j) { o1[j] = (x1[j] * cs[j] - x2[j] * sn[j]) * sc; o2[j] = (x1[j] * sn[j] + x2[j] * cs[j]) * sc; }
                v4u w1, w2; w1.x = pk2(o1[0], o1[1]); w1.y = pk2(o1[2], o1[3]); w1.z = pk2(o1[4], o1[5]); w1.w = pk2(o1[6], o1[7]); w2.x = pk2(o2[0], o2[1]); w2.y = pk2(o2[2], o2[3]); w2.z = pk2(o2[4], o2[5]); w2.w = pk2(o2[6], o2[7]);
                const int base = which ? SC_KS : SC_QS;
                *(LAS v4u*)(lds + base + row * SC_QROW + 16 * ch) = w1; *(LAS v4u*)(lds + base + row * SC_QROW + 16 * (ch + 8)) = w2;
            }
        }
#pragma unroll
        for (int i = 0; i < 4; ++i) { const int cc = tid + 512 * i, row = cc >> 5, ch = cc & 31; *(LAS v4u*)(lds + SC_VS + row * SC_VROW + 16 * ch) = pv[i]; }
        const float ig_c = pig, f_c = pfg;
        __syncthreads();
        if (!RET && !(SKIP & 1)) {
            if (w == 0) {
                const float ig = ig_c, f = f_c;
                const float lf = fminf(f, 0.f) - log1pf(expf(-fabsf(f)));
                float b = lf;
                b += dppk<0x111>(0.f, b); b += dppk<0x112>(0.f, b); b += dppk<0x114>(0.f, b); b += dppk<0x118>(0.f, b);
                { const float r1 = rdlane(b, 15), r2 = rdlane(b, 31), r3 = rdlane(b, 47); const int row = lane >> 4;
                  b += (row >= 1 ? r1 : 0.f) + (row >= 2 ? r2 : 0.f) + (row >= 3 ? r3 : 0.f); }
                const float a = ig - b; float am = a;
                am = fmaxf(am, dppk<0x111>(-3.0e38f, am)); am = fmaxf(am, dppk<0x112>(-3.0e38f, am)); am = fmaxf(am, dppk<0x114>(-3.0e38f, am)); am = fmaxf(am, dppk<0x118>(-3.0e38f, am));
                { const float r1 = rdlane(am, 15), r2 = rdlane(am, 31), r3 = rdlane(am, 47); const int row = lane >> 4;
                  am = fmaxf(am, fmaxf(row >= 1 ? r1 : -3.0e38f, fmaxf(row >= 2 ? r2 : -3.0e38f, row >= 3 ? r3 : -3.0e38f))); }
                const float mst = SC_[0];
                const float Mx = fmaxf(mst, am);
                A_[lane] = a * 1.4426950408889634f; MX_[lane] = Mx * 1.4426950408889634f + 3.5f; PS_[lane] = expf(mst - Mx); EM_[lane] = expf(-b - Mx);
                const float M63 = rdlane(Mx, 63), b63 = rdlane(b, 63);
                WS_[lane] = expf(a - M63);
                if (lane == 0) { SC_[1] = expf(mst - M63); SC_[0] = b63 + M63; }
            } else if (w == 1) {
                float acc = 0.f;
#pragma unroll
                for (int ch = 0; ch < 16; ++ch) { const v4u qv = *(const LAS v4u*)(lds + SC_QS + lane * SC_QROW + 16 * ch); const LAS float* nv = NV_ + 8 * ch;
                    acc += blo(qv.x) * nv[0] + bhi(qv.x) * nv[1] + blo(qv.y) * nv[2] + bhi(qv.y) * nv[3] + blo(qv.z) * nv[4] + bhi(qv.z) * nv[5] + blo(qv.w) * nv[6] + bhi(qv.w) * nv[7]; }
                NQ_[lane] = acc;
            }
        }
        __syncthreads();
        SC_LAUNDER();
        if (!(SKIP & 32))
#pragma unroll 1
        for (int i = 0; i < 2; ++i) { const int cc = tid + 512 * i, row = cc >> 4, ch = cc & 15; const v4u kv = *(const LAS v4u*)(lds + SC_KS + row * SC_QROW + 16 * ch);
            const float f = WS_[row] * (RET ? 1.0f : KSCALE);
            v4u o; o.x = pk2(blo(kv.x) * f, bhi(kv.x) * f); o.y = pk2(blo(kv.y) * f, bhi(kv.y) * f); o.z = pk2(blo(kv.z) * f, bhi(kv.z) * f); o.w = pk2(blo(kv.w) * f, bhi(kv.w) * f);
            *(LAS v4u*)(lds + SC_KSC + row * SC_KCROW + 16 * ch) = o; }
        f32x16 Zl[2];
#pragma unroll
        for (int lb = 0; lb < 2; ++lb)
#pragma unroll
            for (int i = 0; i < 16; ++i) Zl[lb][i] = 0.f;
        __builtin_amdgcn_sched_barrier(0);
        if (!(SKIP & 2))
#pragma unroll
        for (int db = 0; db < 4; ++db) {
            const bf16x8 cfa = pack8(Cacc[db][0], Cacc[db][1], Cacc[db][2], Cacc[db][3], Cacc[db][4], Cacc[db][5], Cacc[db][6], Cacc[db][7]);
            const bf16x8 cfb = pack8(Cacc[db][8], Cacc[db][9], Cacc[db][10], Cacc[db][11], Cacc[db][12], Cacc[db][13], Cacc[db][14], Cacc[db][15]);
#pragma unroll
            for (int lb = 0; lb < 2; ++lb) {
                const LAS unsigned char* qb_ = lds + SC_QS + (32 * lb + r) * SC_QROW + (32 * db + 4 * hh) * 2;
                const s16x4 lo0 = *(const LAS s16x4*)(qb_), hi0 = *(const LAS s16x4*)(qb_ + 16), lo1 = *(const LAS s16x4*)(qb_ + 32), hi1 = *(const LAS s16x4*)(qb_ + 48);
                Zl[lb] = MFMA32(cat4(lo0, hi0), cfa, Zl[lb]);
                Zl[lb] = MFMA32(cat4(lo1, hi1), cfb, Zl[lb]);
            }
        }
#pragma unroll
        for (int lb = 0; lb < 2; ++lb)
#pragma unroll
            for (int q = 0; q < 4; ++q) { const f32x4 pv4 = *(const LAS f32x4*)(PS_ + 32 * lb + 8 * q + 4 * hh); Zl[lb][4 * q] *= pv4.x; Zl[lb][4 * q + 1] *= pv4.y; Zl[lb][4 * q + 2] *= pv4.z; Zl[lb][4 * q + 3] *= pv4.w; }
        __builtin_amdgcn_sched_barrier(0);
        SC_LAUNDER();
        v2u zgr[8];
#pragma unroll
        for (int i = 0; i < 8; ++i) zgr[i] = *(const v2u*)(Zc + (unsigned)((8 * w + i) * ZSW + (RET ? ZS_RG : ZS_MO) + hd * 256 + 4 * lane) * 2u);
        float den[2] = {0.f, 0.f};
        if (!(SKIP & 4))
#pragma unroll
        for (int blkid = 0; blkid < 3; ++blkid) {
            const int sb = blkid == 2 ? 1 : 0, lb = blkid == 0 ? 0 : 1;
            f32x16 wt;
#pragma unroll
            for (int i = 0; i < 16; ++i) wt[i] = 0.f;
#pragma unroll
            for (int s = 0; s < 8; ++s) {
                const bf16x8 ka = *(const LAS bf16x8*)(lds + SC_KS + (32 * sb + r) * SC_QROW + (16 * s + 8 * hh) * 2);
                const bf16x8 qb = *(const LAS bf16x8*)(lds + SC_QS + (32 * lb + r) * SC_QROW + (16 * s + 8 * hh) * 2);
                wt = MFMA32(ka, qb, wt);
            }
            const int l = 32 * lb + r; const float Ml = MX_[l];
#pragma unroll
            for (int q = 0; q < 4; ++q) { const f32x4 av4 = *(const LAS f32x4*)(A_ + 32 * sb + 8 * q + 4 * hh); const float av[4] = {av4.x, av4.y, av4.z, av4.w};
#pragma unroll
                for (int k = 0; k < 4; ++k) { const int i = 4 * q + k; const int si = 32 * sb + crow(i, hh); const float e = __builtin_amdgcn_exp2f(av[k] - Ml); const float fct = (sb != lb || si <= l) ? e : 0.f; wt[i] *= fct; den[lb] += wt[i]; } }
#pragma unroll
            for (int sp = 0; sp < 2; ++sp) {
                const bf16x8 wf = pack8(wt[8 * sp], wt[8 * sp + 1], wt[8 * sp + 2], wt[8 * sp + 3], wt[8 * sp + 4], wt[8 * sp + 5], wt[8 * sp + 6], wt[8 * sp + 7]);
                const s16x4 lo = trrd(lds + SC_VS + (32 * sb + 16 * sp + 4 * hh + q4) * SC_VROW + (v0 + 16 * blk + 4 * p4) * 2);
                const s16x4 hi = trrd(lds + SC_VS + (32 * sb + 16 * sp + 8 + 4 * hh + q4) * SC_VROW + (v0 + 16 * blk + 4 * p4) * 2);
                Zl[lb] = MFMA32(wf, cat4(lo, hi), Zl[lb]);
            }
            __builtin_amdgcn_sched_barrier(0);
        }
        if (!RET) {
#pragma unroll
            for (int lb = 0; lb < 2; ++lb) { const int l = 32 * lb + r; const float d = den[lb] + __shfl_xor(den[lb], 32) + PS_[l] * NQ_[l];
                const float rd = 1.0f / fmaxf(fabsf(d), EM_[l]); if (hh == 0) RDW_[l] = rd; }
#pragma unroll
            for (int lb = 0; lb < 2; ++lb)
#pragma unroll
                for (int q = 0; q < 4; ++q) { const f32x4 rv4 = *(const LAS f32x4*)(RDW_ + 32 * lb + 8 * q + 4 * hh); Zl[lb][4 * q] *= rv4.x; Zl[lb][4 * q + 1] *= rv4.y; Zl[lb][4 * q + 2] *= rv4.z; Zl[lb][4 * q + 3] *= rv4.w; }
        }
#pragma unroll
        for (int lb = 0; lb < 2; ++lb)
#pragma unroll
            for (int i = 0; i < 16; ++i) *(LAS unsigned short*)(lds + SC_HT + (32 * lb + crow(i, hh)) * SC_HROW + (v0 + r) * 2) = (unsigned short)f2bf(Zl[lb][i]);
        if (c + 1 < nch && ((c + 1) & 3) == 0) SC_POLL(c + 1);
        __syncthreads();
        SC_LAUNDER();
        if (c + 1 < nch) SC_LOAD(c + 1);
        if (!(SKIP & 8))
        {
            const float carry = SC_[1];
#pragma unroll
            for (int db = 0; db < 4; ++db) Cacc[db] = Cacc[db] * carry;
            f32x16 nacc;
#pragma unroll
            for (int i = 0; i < 16; ++i) nacc[i] = 0.f;
            const bf16x8 ones = (bf16x8){0x3F80, 0x3F80, 0x3F80, 0x3F80, 0x3F80, 0x3F80, 0x3F80, 0x3F80};
#pragma unroll
            for (int sp = 0; sp < 4; ++sp) {
                const s16x4 vlo = trrd(lds + SC_VS + (16 * sp + 8 * hh + q4) * SC_VROW + (v0 + 16 * blk + 4 * p4) * 2);
                const s16x4 vhi = trrd(lds + SC_VS + (16 * sp + 8 * hh + 4 + q4) * SC_VROW + (v0 + 16 * blk + 4 * p4) * 2);
                const bf16x8 vb = cat4(vlo, vhi);
#pragma unroll
                for (int db = 0; db < 4; ++db) {
                    const s16x4 klo = trrd(lds + SC_KSC + (16 * sp + 8 * hh + q4) * SC_KCROW + (32 * db + 16 * blk + 4 * p4) * 2);
                    const s16x4 khi = trrd(lds + SC_KSC + (16 * sp + 8 * hh + 4 + q4) * SC_KCROW + (32 * db + 16 * blk + 4 * p4) * 2);
                    const bf16x8 ka = cat4(klo, khi);
                    Cacc[db] = MFMA32(ka, vb, Cacc[db]);
                    if (!RET && db == w) nacc = MFMA32(ka, ones, nacc);
                }
            }
            if (!RET && w < 4 && r == 0) {
#pragma unroll
                for (int i = 0; i < 16; ++i) { const int d = 32 * w + crow(i, hh); NV_[d] = carry * NV_[d] + nacc[i]; }
            }
        }
        __builtin_amdgcn_sched_barrier(0);
        SC_LAUNDER();
        if (!(SKIP & 16))
        {
            const float* gain = (RET ? cin(C, 18) : cin(C, 11)) + layer * 1024 + hd * 256 + 4 * lane;
            const f32x4 gg = *(const f32x4*)gain;
#pragma unroll
            for (int i = 0; i < 8; ++i) {
                const int l = 8 * w + i;
                const v2u hv = *(const LAS v2u*)(lds + SC_HT + l * SC_HROW + 8 * lane);
                float x0 = blo(hv.x), x1 = bhi(hv.x), x2 = blo(hv.y), x3 = bhi(hv.y);
                if (RET) { const float mean = wave_sum((x0 + x1) + (x2 + x3)) * (1.f / 256.f); x0 -= mean; x1 -= mean; x2 -= mean; x3 -= mean; }
                const float rs = rsqrtf(wave_sum((x0 * x0 + x1 * x1) + (x2 * x2 + x3 * x3)) * (1.f / 256.f) + EPS);
                const v2u zg = zgr[i];
                v2u o; o.x = pk2(x0 * rs * gg.x * blo(zg.x), x1 * rs * gg.y * bhi(zg.x)); o.y = pk2(x2 * rs * gg.z * blo(zg.y), x3 * rs * gg.w * bhi(zg.y));
                if (!DRY) *(v2u*)(Yc + (unsigned)(l * YW + (RET ? 2048 : 0) + hd * 256 + 4 * lane) * 2u) = o; else asm volatile("" :: "v"(o.x), "v"(o.y));
            }
        }
        __syncthreads();
    }
    SC_LAUNDER();
    if (!DRY)
    {
        float* ob = C.out;
        if (!RET) {
            float* co = ob + (sample ? O_SC : O_PC) + sidx * 256 * 128 + (size_t)(v0 + r) * 128;
#pragma unroll
            for (int db = 0; db < 4; ++db)
#pragma unroll
                for (int q = 0; q < 4; ++q) { const f32x4 t = {Cacc[db][4 * q], Cacc[db][4 * q + 1], Cacc[db][4 * q + 2], Cacc[db][4 * q + 3]}; *(f32x4*)(co + 32 * db + 8 * q + 4 * hh) = t; }
            if (tid < 128) ob[(sample ? O_SN : O_PN) + sidx * 128 + tid] = NV_[tid];
            if (tid == 0) ob[(sample ? O_SM : O_PM) + sidx] = SC_[0];
        } else {
            float* ro = ob + (sample ? O_SR : O_PR) + sidx * 128 * 256 + v0 + r;
#pragma unroll
            for (int db = 0; db < 4; ++db)
#pragma unroll
                for (int i = 0; i < 16; ++i) ro[(size_t)(32 * db + crow(i, hh)) * 256] = Cacc[db][i];
        }
    }
    __syncthreads();
#undef SC_LOAD
#undef SC_POLL
#undef SC_ZROW
#undef SC_LAUNDER
}

__device__ __forceinline__ void scan_phase(Ctx& C, int layer, int rep, const unsigned* ready) {
    volatile LAS unsigned* WQ = (volatile LAS unsigned*)(C.lds + MISC_OFF);
    unsigned* ctr = (unsigned*)(C.ws + WS_CTL) + 8 + layer + 16 * rep;
    for (;;) {
        { int t_ = C.lane; asm volatile("" : "+v"(t_)); if (C.wave == 0 && t_ == 0) WQ[0] = __hip_atomic_fetch_add(ctr, 1u, __ATOMIC_RELAXED, __HIP_MEMORY_SCOPE_AGENT); }
        __syncthreads();
        int it = (int)WQ[0];
        __syncthreads();
        if (it >= 64) break;
        if (it < 32) { scan_unit<false, true>(C, layer, it >> 2, it & 3, ready, 8u * (ZSW / 256)); continue; } it -= 32;
        scan_unit<true, true>(C, layer, it >> 2, it & 3, ready, 8u * (ZSW / 256));
    }
    if (layer == 0 && rep == 0) {
        unsigned* ctr2 = (unsigned*)(C.ws + WS_CTL) + 12;
        LAS float* scr = (LAS float*)(C.lds + C.wave * 16384);
        for (;;) {
            { int t_ = C.lane; asm volatile("" : "+v"(t_)); if (C.wave == 0 && t_ == 0) WQ[0] = __hip_atomic_fetch_add(ctr2, 1u, __ATOMIC_RELAXED, __HIP_MEMORY_SCOPE_AGENT); }
            __syncthreads();
            const int ch = (int)WQ[0];
            __syncthreads();
            constexpr int W_L0REST = W_NITEMS - W_I_IN - W_I_UQ - 2 * W_I_UK;
            if (ch * 64 >= W_L0REST + W_NITEMS) break;
#pragma unroll 1
            for (int j = 0; j < 8; ++j) { const int it2 = ch * 64 + j * 8 + C.wave;
                if (it2 < W_L0REST) weight_item(C, 0, W_I_IN + it2, scr); else if (it2 < W_L0REST + W_NITEMS) weight_item(C, 1, it2 - W_L0REST, scr); }
        }
    }
}
__device__ __forceinline__ void attn_phase(Ctx& C, int layer, int g, int rep) {
    volatile LAS unsigned* WQ = (volatile LAS unsigned*)(C.lds + MISC_OFF);
    unsigned* ctr = (unsigned*)(C.ws + WS_CTL) + (layer * 3 + g) + 16 * rep;
    const int nbg = g < 2 ? 3 : 2;
    const int n_pa = nbg * 8 * 16;
    const int n_sa = g == 2 ? 64 : 0;
    for (;;) {
        { int t_ = C.lane; asm volatile("" : "+v"(t_)); if (C.wave == 0 && t_ == 0) WQ[0] = __hip_atomic_fetch_add(ctr, 1u, __ATOMIC_RELAXED, __HIP_MEMORY_SCOPE_AGENT); }
        __syncthreads();
        int it = (int)WQ[0];
        __syncthreads();
        if (it >= n_pa + n_sa) break;
        if (it < n_pa) { int qt, rem; if (g < 2) { qt = 15 - it / 24; rem = it % 24; } else { qt = 15 - (it >> 4); rem = it & 15; } attn_unit(C, g, false, rem >> 3, rem & 7, qt); continue; } it -= n_pa;
        attn_unit(C, g, true, it >> 3, it & 7, 0);
    }
}

typedef GAS unsigned gu32;
#define XB_TMO      128
#define XB_XCNT(j)  (256  + 64 * (j))
#define XB_XSUB(j)  (1280 + 64 * (j))
#define XB_XGEN(j)  (2304 + 64 * (j))
#define XB_TOP      3328
#define XB_TOPGEN   3392
#define XCD_BAR_WORDS 3456
#define XB_SPIN_CAP (1u << 18)

__device__ __forceinline__ unsigned xb_ld(unsigned* p)              { return __hip_atomic_load(p, __ATOMIC_RELAXED, __HIP_MEMORY_SCOPE_AGENT); }
__device__ __forceinline__ unsigned xb_add(unsigned* p, unsigned v) { return __hip_atomic_fetch_add(p, v, __ATOMIC_RELAXED, __HIP_MEMORY_SCOPE_AGENT); }
__device__ __forceinline__ unsigned xb_xcc_id() { return (unsigned)__builtin_amdgcn_s_getreg((3 << 11) | 20) & 0xFu; }
#define XB_SPIN(cond, bar) do { unsigned _sp = 0; while (cond) { __builtin_amdgcn_s_sleep(1); \
    if ((++_sp & 255u) == 0u) { if (xb_ld(&(bar)[XB_TMO])) break; if (_sp > XB_SPIN_CAP) { atomicAdd(&(bar)[XB_TMO], 1u); break; } } } } while (0)

struct XcdBarrier {
    unsigned* bar; unsigned x;
    volatile LAS unsigned* st;
};

__device__ __forceinline__ XcdBarrier xcd_barrier_post(unsigned* bar, volatile LAS unsigned* st) {
    XcdBarrier b; b.bar = bar; b.x = xb_xcc_id(); b.st = st;
    if (threadIdx.x == 0) (void)xb_add(&bar[XB_XCNT(b.x)], 1u);
    return b;
}
__device__ __forceinline__ void xcd_barrier_complete(unsigned* bar, unsigned x, unsigned& nloc, unsigned& nx) {
    const unsigned G = gridDim.x * gridDim.y * gridDim.z;
    unsigned sum, cnt, mine, sp = 0u;
    for (;;) {
        sum = 0u; cnt = 0u; mine = 0u;
#pragma unroll
        for (unsigned j = 0; j < 16; ++j) { const unsigned c = xb_ld(&bar[XB_XCNT(j)]); sum += c; cnt += (c > 0u) ? 1u : 0u; mine = (j == x) ? c : mine; }
        if (sum == G) break;
        __builtin_amdgcn_s_sleep(1);
        if ((++sp & 255u) == 0u) { if (xb_ld(&bar[XB_TMO])) break; if (sp > XB_SPIN_CAP) { atomicAdd(&bar[XB_TMO], 1u); break; } }
    }
    nloc = mine > 0u ? mine : 1u; nx = cnt > 0u ? cnt : 1u;
}

__device__ __forceinline__ void xcd_barrier(const XcdBarrier& b) {
    asm volatile("s_waitcnt vmcnt(0)" ::: "memory");
    __syncthreads();
    if (threadIdx.x == 0) {
        unsigned* bar = b.bar;
        __builtin_amdgcn_s_waitcnt(0);
        unsigned nloc = b.st[0], nx = b.st[1];
        if (nloc == 0u) { xcd_barrier_complete(bar, b.x, nloc, nx); b.st[0] = nloc; b.st[1] = nx; }
        const unsigned old = xb_add(&bar[XB_XSUB(b.x)], 1u);
        const unsigned gen = old / nloc;
        if (old + 1u == (gen + 1u) * nloc) {
            __builtin_amdgcn_fence(__ATOMIC_RELEASE, "agent");
            asm volatile("s_waitcnt vmcnt(0)" ::: "memory");
            const unsigned og = xb_add(&bar[XB_TOP], 1u);
            const unsigned tg = og / nx;
            if (og + 1u == (tg + 1u) * nx) xb_add(&bar[XB_TOPGEN], 1u);
            else XB_SPIN(xb_ld(&bar[XB_TOPGEN]) == tg, bar);
            __builtin_amdgcn_fence(__ATOMIC_ACQUIRE, "agent");
            xb_add(&bar[XB_XGEN(b.x)], 1u);
            asm volatile("s_waitcnt vmcnt(0)" ::: "memory");
        } else {
            XB_SPIN(xb_ld(&bar[XB_XGEN(b.x)]) == gen, bar);
            __builtin_amdgcn_fence(__ATOMIC_ACQUIRE, "agent");
            asm volatile("s_waitcnt vmcnt(0)" ::: "memory");
        }
    }
    __syncthreads();
}

constexpr int CW_BAR = 4096;
#ifndef EN_MASK
#define EN_MASK 1023
#endif
constexpr int EN = EN_MASK;
__global__ void __launch_bounds__(NTHR, 2) mega_fwd(Args args) {
    extern __shared__ __attribute__((aligned(16))) unsigned char lds_raw[];
    cg::grid_group grid = cg::this_grid();
    Ctx C;
    C.lds = (LAS unsigned char*)lds_raw; C.tid = threadIdx.x; C.lane = C.tid & 63; C.wave = __builtin_amdgcn_readfirstlane(C.tid >> 6); C.G = gridDim.x; C.bid = blockIdx.x;
    if (C.tid == 0) {
#pragma unroll
        for (int i = 0; i < 26; ++i) *(LAS unsigned long long*)(C.lds + MISC_OFF + 64 + 8 * i) = (unsigned long long)args.in[i];
    }
    C.out = args.out; C.ws = args.ws;
    if (C.tid == 0) { ((volatile LAS unsigned*)(C.lds + MISC_OFF))[4] = 0u; ((volatile LAS unsigned*)(C.lds + MISC_OFF))[5] = 0u; }
    __syncthreads();
    XcdBarrier bar = xcd_barrier_post((unsigned*)(C.ws + WS_CTL) + CW_BAR, (volatile LAS unsigned*)(C.lds + MISC_OFF) + 4);
#define PHASE_BEGIN { asm volatile("" : "+s"(C.ws), "+s"(C.out)); asm volatile("" : "+s"(C.bid), "+s"(C.G));
#define PHASE_END(dosync) if (dosync) xcd_barrier(bar); }
#define PHASE_END_CG(dosync) if (dosync) grid.sync(); }
    LAS unsigned char* ring = C.lds;
    bf16* XB = (bf16*)(C.ws + WS_XB);

    PHASE_BEGIN if (EN & 1) p0_prologue(C); PHASE_END_CG(true)

    for (int layer = 0; layer < 2; ++layer) {
        PHASE_BEGIN {
            unsigned* ready = (unsigned*)(C.ws + WS_CTL) + 8192 + layer * 2080;
            if (C.bid < 64) {
                const int it = C.bid;
                if (it < 32) scan_unit<false, false>(C, layer, it >> 2, it & 3, ready, 8u * (ZSW / 256));
                else scan_unit<true, false>(C, layer, (it - 32) >> 2, it & 3, ready, 8u * (ZSW / 256));
            } else {
                pg8::Gemm gm{XB, WPTR(layer, WO_IN), MT, ZSW, DM}; pg8::ChunkOrder S; S.init(ZSW / 256, C.G - 64, C.bid - 64, ready);
                pg8::EpiBf16 E{GPTR(GO_ZS), ZSW, (const float*)(C.ws + WS_W + (size_t)layer * W_LAYER + WO_BIAS), 1 | 256, -1, -1};
                pg8::gemm_phase<pg8::EpiBf16, pg8::ChunkOrder, true, true>(ring, gm, S, E);
            }
            scan_phase(C, layer, 0, ready);
        } PHASE_END(true)
        for (int g = 0; g < 3; ++g) {
            const int rows = grp_rows(g), r0 = grp_row0(g), ckr = grp_ck(g);
            PHASE_BEGIN if (EN & 2) {
                pg8::Gemm gm{XB + (size_t)r0 * DM, WPTR(layer, WO_IN) + (size_t)ZSW * DM, rows, ZRW, DM}; pg8::StaticOrder S; S.init(rows, ZRW, C.G, C.bid);
                pg8::EpiBf16 E{GPTR(GO_Z), ZRW, (const float*)(C.ws + WS_W + (size_t)layer * W_LAYER + WO_BIAS) + ZSW, 2, -1, -1};
                pg8::gemm_phase<pg8::EpiBf16, pg8::StaticOrder, true, true>(ring, gm, S, E);
            } PHASE_END(true)
            PHASE_BEGIN if (EN & 4) pe_phase(C, layer, g); PHASE_END(true)
            PHASE_BEGIN if (EN & 8) {
                pg8::Gemm gm{GPTR(GO_QN), WPTR(layer, WO_UQ), 0, 0, 512, 512, 1 << 20, 0, GPTR(GO_CK), WPTR(layer, WO_UK), WPTR(layer, WO_V), GPTR(GO_CK)};
                pg8::TriOrder S; S.init(rows / 256, 6, ckr / 256, 4, 4, ckr / 256, C.G, C.bid);
                pg8::EpiBf16 E{GPTR(GO_QA), 1536, nullptr, 0, -1, -1, GPTR(GO_KN), 1024, GPTR(GO_VT), ckr};
                pg8::gemm_phase<pg8::EpiBf16, pg8::TriOrder, true, true>(ring, gm, S, E);
            } PHASE_END(true)
            PHASE_BEGIN if (EN & 16) attn_phase(C, layer, g, 0); PHASE_END(true)
            PHASE_BEGIN if (EN & 32) {
                pg8::Gemm gm{GPTR(GO_Y) + (size_t)r0 * YW, WPTR(layer, WO_UP), rows, DM, YW}; pg8::StaticOrder S; S.init(rows, DM, C.G, C.bid);
                pg8::EpiUp E{XB + (size_t)r0 * DM, DM, GPTR(GO_Z), 16, 32};
                pg8::gemm_phase<pg8::EpiUp, pg8::StaticOrder, true, true>(ring, gm, S, E);
            } PHASE_END(true)
        }
        PHASE_BEGIN if (EN & 64) {
            { pg8::Gemm gm{XB, WPTR(layer, WO_O), MP, DM, DM}; pg8::StaticOrder S; S.init(MP, DM, C.G, C.bid);
              pg8::EpiBf16 E{GPTR(GO_MIX), DM, nullptr, 0, -1, -1}; pg8::gemm_phase<pg8::EpiBf16, pg8::StaticOrder, true, true>(ring, gm, S, E); }
            { pg8::Gemm gm{XB + (size_t)MP * DM, WPTR(layer, WO_O), MS * 4, DM, 512, DM, 2, 512}; pg8::StaticOrder S; S.init(MS * 4, DM, C.G, C.bid);
              pg8::EpiBf16 E{GPTR(GO_TP), DM, nullptr, 0, -1, -1}; pg8::gemm_phase<pg8::EpiBf16, pg8::StaticOrder, true, true>(ring, gm, S, E); }
        } PHASE_END(true)
        PHASE_BEGIN if (EN & 128) px_phase(C, GPTR(GO_MIX), GPTR(GO_TP), 4, cin(C, 21) + layer * DM, cin(C, 22) + layer * DM, layer == 0); PHASE_END(true)
        PHASE_BEGIN if (EN & 256) {
            pg8::Gemm gm{XB, WPTR(layer, WO_GU), MT, 2 * DFF, DM}; pg8::StaticOrder S; S.init(MT, 2 * DFF, C.G, C.bid);
            pg8::EpiSwi E{GPTR(GO_ACT), DFF, -1, -1};
            pg8::gemm_phase<pg8::EpiSwi, pg8::StaticOrder, true, true>(ring, gm, S, E);
        } PHASE_END(true)
        PHASE_BEGIN if (EN & 512) {
            { pg8::Gemm gm{GPTR(GO_ACT), WPTR(layer, WO_DOWN), MP, DM, DFF}; pg8::StaticOrder S; S.init(MP, DM, C.G, C.bid);
              pg8::EpiBf16 E{GPTR(GO_MIX), DM, nullptr, 0, -1, -1}; pg8::gemm_phase<pg8::EpiBf16, pg8::StaticOrder, true, true>(ring, gm, S, E); }
            { pg8::Gemm gm{GPTR(GO_ACT) + (size_t)MP * DFF, WPTR(layer, WO_DOWN), MS * 11, DM, 512, DFF, 2, 512}; pg8::StaticOrder S; S.init(MS * 11, DM, C.G, C.bid);
              pg8::EpiBf16 E{GPTR(GO_TP), DM, nullptr, 0, -1, -1}; pg8::gemm_phase<pg8::EpiBf16, pg8::StaticOrder, true, true>(ring, gm, S, E); }
        } PHASE_END(true)
        PHASE_BEGIN if (EN & 128) px_phase(C, GPTR(GO_MIX), GPTR(GO_TP), 11, cin(C, 25) + layer * DM, layer == 0 ? cin(C, 8) + DM : nullptr, false); PHASE_END(true)
    }
#undef PHASE_BEGIN
#undef PHASE_END
#undef PHASE_END_CG
}

extern "C" void kernel_launch(void* const* d_in, const int* in_sizes, int n_in, void* d_out, int out_size, void* d_ws, size_t ws_size, hipStream_t stream) {
    static int grid = 0;
    if (grid == 0) {
        if (n_in != 26 || in_sizes[0] != MP * DM || (size_t)out_size != O_END || ws_size < WS_END) {
            fprintf(stderr, "kernel_launch: shape mismatch n_in %d in0 %d out %d ws %zu (need %zu)\n", n_in, n_in > 0 ? in_sizes[0] : -1, out_size, ws_size, (size_t)WS_END); grid = -1; return; }
        int dev = 0, cus = 0, per_cu = 0;
        hipGetDevice(&dev); hipDeviceGetAttribute(&cus, hipDeviceAttributeMultiprocessorCount, dev);
        hipFuncSetAttribute((const void*)mega_fwd, hipFuncAttributeMaxDynamicSharedMemorySize, LDS_BYTES);
        hipOccupancyMaxActiveBlocksPerMultiprocessor(&per_cu, (const void*)mega_fwd, NTHR, LDS_BYTES);
        (void)hipGetLastError();
        if (per_cu < 1) per_cu = 1;
        grid = cus * 1;
        if (grid <= 0) grid = 256;
    }
    if (grid < 0) return;
    if (hipMemsetAsync((char*)d_ws + WS_CTL, 0, 65536, stream) != hipSuccess) { fprintf(stderr, "memset failed\n"); return; }
    Args a{};
    for (int i = 0; i < 26; ++i) a.in[i] = (const float*)d_in[i];
    a.out = (float*)d_out; a.ws = (unsigned char*)d_ws; a.ph_lo = 0; a.ph_hi = 1000;
    void* kargs[] = {&a};
    hipError_t e = hipLaunchCooperativeKernel((const void*)mega_fwd, dim3(grid), dim3(NTHR), kargs, LDS_BYTES, stream);
    if (e != hipSuccess) fprintf(stderr, "cooperative launch failed: %s (grid %d)\n", hipGetErrorString(e), grid);
}
```
